# Optimizing an MI355X kernel written in HIP

```python
import math
import jax, jax.numpy as jnp
from jax import lax
import numpy as np


D_MODEL = 1024
BATCH = 16
SEQ = 2048
DEPTH = 1

ATTN_HEADS = 16
ATTN_HEAD_DIM = 64
ATTN_WIDTH = ATTN_HEADS * ATTN_HEAD_DIM
ATTN_SCALE = ATTN_HEAD_DIM ** -0.5
MOBA_BLOCK = 256
MOBA_TOPK = 3
Q_BLOCK = 128
REL_BUCKETS = 32
REL_MAX_EXACT = 16
REL_MAX_DISTANCE = 1024
SSM_EXPAND = 2
SSM_INNER = SSM_EXPAND * D_MODEL
SSM_HEAD_DIM = 64
SSM_HEADS = SSM_INNER // SSM_HEAD_DIM
SSM_GROUPS = 4
SSM_HEADS_PER_GROUP = SSM_HEADS // SSM_GROUPS
SSM_STATE = 128
SSM_CONV = 4
SSM_CHUNK = 128
SSM_CONV_DIM = SSM_INNER + 2 * SSM_GROUPS * SSM_STATE
N_EXPERTS = 32
TOP_K = 4
EXPERT_FF = D_MODEL
SWIGLU_LIMIT = 7.0
SWIGLU_ALPHA = 1.702
MOE_BLOCK = 128
N_BRANCHES = 2
IN_PROJ_DIM = 3 * ATTN_WIDTH + SSM_INNER + SSM_CONV_DIM + SSM_HEADS + N_BRANCHES * D_MODEL
EPS = 1e-6

kernel_name = 'hybrid_moba_mamba2_moe_adaln'


def rms_norm(x, g):
    xf = x.astype(jnp.float32)
    y = xf * lax.rsqrt(jnp.mean(xf * xf, axis=-1, keepdims=True) + EPS)
    return (y * g.astype(jnp.float32)).astype(x.dtype)


def t5_bucket(dist):
    is_small = dist < REL_MAX_EXACT
    d = jnp.maximum(dist, 1).astype(jnp.float32)
    large = REL_MAX_EXACT + (jnp.log(d / REL_MAX_EXACT) / math.log(REL_MAX_DISTANCE / REL_MAX_EXACT)
                             * (REL_BUCKETS - REL_MAX_EXACT)).astype(jnp.int32)
    large = jnp.minimum(large, REL_BUCKETS - 1)
    return jnp.where(is_small, dist, large)


def moba_attention_single(q, k, v, rel_table):
    S = q.shape[0]
    s_pad = -(-S // MOBA_BLOCK) * MOBA_BLOCK
    pad = ((0, s_pad - S), (0, 0), (0, 0))
    q, k, v = (jnp.pad(t, pad).transpose(1, 0, 2) for t in (q, k, v))
    n_blocks = s_pad // MOBA_BLOCK
    n_sel = min(MOBA_TOPK, n_blocks)
    kb = k.reshape(ATTN_HEADS, n_blocks, MOBA_BLOCK, ATTN_HEAD_DIM)
    vb = v.reshape(ATTN_HEADS, n_blocks, MOBA_BLOCK, ATTN_HEAD_DIM)
    k_mean = jnp.mean(kb.astype(jnp.float32), axis=2)
    q_blk = jnp.arange(s_pad) // MOBA_BLOCK
    fully_past = jnp.arange(n_blocks)[None, :] < q_blk[:, None]
    gate = jnp.einsum('hsd,hnd->hsn', q.astype(jnp.float32), k_mean)
    _, sel = lax.top_k(jnp.where(fully_past[None], gate, -jnp.inf), n_sel)
    sel_ok = jnp.arange(n_sel)[None, :] < q_blk[:, None]
    table_t = rel_table.T.astype(jnp.float32)
    h_ix = jnp.arange(ATTN_HEADS)[:, None, None]
    key_off = jnp.arange(MOBA_BLOCK)

    def query_block(args):
        qb, idx, ok, q0 = args
        q_pos = q0 + jnp.arange(Q_BLOCK)
        k_sel = kb[h_ix, idx]
        v_sel = vb[h_ix, idx]
        s_past = jnp.einsum('hqd,hqntd->hqnt', qb, k_sel).astype(jnp.float32) * ATTN_SCALE
        dist_past = q_pos[None, :, None, None] - (idx[..., None] * MOBA_BLOCK + key_off)
        s_past = s_past + table_t[h_ix[..., None], t5_bucket(jnp.maximum(dist_past, 0))]
        own = q0 // MOBA_BLOCK
        k_own = lax.dynamic_index_in_dim(kb, own, axis=1, keepdims=False)
        v_own = lax.dynamic_index_in_dim(vb, own, axis=1, keepdims=False)
        dist_own = q_pos[:, None] - (own * MOBA_BLOCK + key_off)[None, :]
        s_own = (jnp.einsum('hqd,htd->hqt', qb, k_own).astype(jnp.float32) * ATTN_SCALE
                 + table_t[:, t5_bucket(jnp.maximum(dist_own, 0))])
        logits = jnp.concatenate([s_past.reshape(ATTN_HEADS, Q_BLOCK, n_sel * MOBA_BLOCK), s_own], axis=-1)
        mask = jnp.concatenate([
            jnp.broadcast_to(ok[None, :, :, None], s_past.shape).reshape(ATTN_HEADS, Q_BLOCK, n_sel * MOBA_BLOCK),
            jnp.broadcast_to((dist_own >= 0)[None], s_own.shape)], axis=-1)
        p = jax.nn.softmax(jnp.where(mask, logits, -jnp.inf), axis=-1).astype(v_own.dtype)
        p_past = p[..., :n_sel * MOBA_BLOCK].reshape(ATTN_HEADS, Q_BLOCK, n_sel, MOBA_BLOCK)
        p_own = p[..., n_sel * MOBA_BLOCK:]
        return (jnp.einsum('hqnt,hqntd->hqd', p_past, v_sel)
                + jnp.einsum('hqt,htd->hqd', p_own, v_own))

    n_qb = s_pad // Q_BLOCK
    xs = (q.reshape(ATTN_HEADS, n_qb, Q_BLOCK, ATTN_HEAD_DIM).transpose(1, 0, 2, 3),
          sel.reshape(ATTN_HEADS, n_qb, Q_BLOCK, n_sel).transpose(1, 0, 2, 3),
          sel_ok.reshape(n_qb, Q_BLOCK, n_sel),
          jnp.arange(n_qb, dtype=jnp.int32) * Q_BLOCK)
    out = lax.map(query_block, xs)
    return out.transpose(0, 2, 1, 3).reshape(s_pad, ATTN_HEADS, ATTN_HEAD_DIM)[:S]


def causal_depthwise_conv(x, w, b):
    K = w.shape[0]
    S = x.shape[1]
    xp = jnp.pad(x, ((0, 0), (K - 1, 0), (0, 0)))
    y = b
    for tap in range(K):
        y = y + xp[:, tap:tap + S] * w[tap]
    return y


def ssd_chunked(xh, dt, a, b_in, c_in):
    Bsz, S = xh.shape[:2]
    nc = S // SSM_CHUNK
    L, G, J = SSM_CHUNK, SSM_GROUPS, SSM_HEADS_PER_GROUP
    xdt = (xh * dt[..., None]).reshape(Bsz, nc, L, G, J, SSM_HEAD_DIM)
    a_dt = (dt * a).reshape(Bsz, nc, L, G, J).transpose(0, 3, 4, 1, 2)
    a_cs = jnp.cumsum(a_dt, axis=-1)
    bc = b_in.reshape(Bsz, nc, L, G, SSM_STATE)
    cc = c_in.reshape(Bsz, nc, L, G, SSM_STATE)
    pos = jnp.arange(L)
    causal = pos[:, None] >= pos[None, :]
    seg = a_cs[..., :, None] - a_cs[..., None, :]
    decay = jnp.where(causal, jnp.exp(jnp.where(causal, seg, 0.0)), 0.0)
    cb = jnp.einsum('bclgn,bcsgn->bcgls', cc, bc)
    y_diag = jnp.einsum('bcgls,bgjcls,bcsgjp->bclgjp', cb, decay, xdt)
    decay_to_end = jnp.exp(a_cs[..., -1:] - a_cs)
    chunk_states = jnp.einsum('bclgn,bgjcl,bclgjp->bcgjpn', bc, decay_to_end, xdt)
    chunk_decay = jnp.exp(a_cs[..., -1])

    def carry_state(h, inp):
        st, dec = inp
        return h * dec[..., None, None] + st, h

    h0 = jnp.zeros_like(chunk_states[:, 0])
    _, prev = lax.scan(carry_state, h0, (jnp.moveaxis(chunk_states, 1, 0), jnp.moveaxis(chunk_decay, -1, 0)))
    prev = jnp.moveaxis(prev, 0, 1)
    y_off = jnp.einsum('bclgn,bcgjpn,bgjcl->bclgjp', cc, prev, jnp.exp(a_cs))
    return (y_diag + y_off).reshape(Bsz, S, SSM_HEADS, SSM_HEAD_DIM)


def mamba2_branch(z, xbc, dt_raw, conv_w, conv_b, dt_bias, a_log, d_skip, ssm_norm_g):
    Bsz, S, _ = z.shape
    xbc = jax.nn.silu(causal_depthwise_conv(xbc, conv_w, conv_b))
    xs, b_in, c_in = jnp.split(xbc, [SSM_INNER, SSM_INNER + SSM_GROUPS * SSM_STATE], axis=-1)
    xs = xs.reshape(Bsz, S, SSM_HEADS, SSM_HEAD_DIM).astype(jnp.float32)
    dt = jax.nn.softplus((dt_raw + dt_bias).astype(jnp.float32))
    a = -jnp.exp(a_log.astype(jnp.float32))
    y = ssd_chunked(xs, dt, a,
                    b_in.reshape(Bsz, S, SSM_GROUPS, SSM_STATE).astype(jnp.float32),
                    c_in.reshape(Bsz, S, SSM_GROUPS, SSM_STATE).astype(jnp.float32))
    y = y + d_skip.astype(jnp.float32)[:, None] * xs
    y = y.reshape(Bsz, S, SSM_INNER) * jax.nn.silu(z.astype(jnp.float32))
    yg = y.reshape(Bsz, S, SSM_GROUPS, SSM_INNER // SSM_GROUPS)
    yg = yg * lax.rsqrt(jnp.mean(yg * yg, axis=-1, keepdims=True) + EPS)
    return (yg.reshape(Bsz, S, SSM_INNER) * ssm_norm_g.astype(jnp.float32)).astype(z.dtype)


def clamped_swiglu(h):
    glu, lin = jnp.split(h, 2, axis=-1)
    glu = jnp.minimum(glu, SWIGLU_LIMIT)
    lin = jnp.clip(lin, -SWIGLU_LIMIT, SWIGLU_LIMIT)
    return glu * jax.nn.sigmoid(SWIGLU_ALPHA * glu) * (lin + 1.0)


def moe_ffn(u, router_w, router_b, w1, b1, w2, b2):
    T, D = u.shape
    logits = (u @ router_w).astype(jnp.float32) + router_b.astype(jnp.float32)
    top_logits, top_e = lax.top_k(logits, TOP_K)
    top_w = jax.nn.softmax(top_logits, axis=-1).astype(u.dtype)
    n_pairs = T * TOP_K
    e_flat = top_e.reshape(-1)
    tok_flat = jnp.arange(n_pairs, dtype=jnp.int32) // TOP_K
    order = jnp.argsort(e_flat)
    e_sorted = e_flat[order]
    tok_sorted = tok_flat[order]
    w_sorted = top_w.reshape(-1)[order]
    counts = jax.ops.segment_sum(jnp.ones(n_pairs, jnp.int32), e_flat, num_segments=N_EXPERTS)
    padded = (counts + MOE_BLOCK - 1) // MOE_BLOCK * MOE_BLOCK
    start = jnp.cumsum(counts) - counts
    p_end = jnp.cumsum(padded)
    p_start = p_end - padded
    dest = p_start[e_sorted] + jnp.arange(n_pairs, dtype=jnp.int32) - start[e_sorted]
    cap = n_pairs + N_EXPERTS * MOE_BLOCK
    n_blocks = cap // MOE_BLOCK
    buf_tok = jnp.zeros(cap, jnp.int32).at[dest].set(tok_sorted)
    buf_w = jnp.zeros(cap, u.dtype).at[dest].set(w_sorted)
    block_e = jnp.minimum(jnp.searchsorted(p_end, jnp.arange(n_blocks) * MOE_BLOCK, side='right'), N_EXPERTS - 1)

    def expert_block(args):
        tok, wt, e = args
        xb = u[tok]
        h = xb @ w1[e] + b1[e]
        y = clamped_swiglu(h) @ w2[e] + b2[e]
        return y * wt[:, None]

    ys = lax.map(expert_block, (buf_tok.reshape(n_blocks, MOE_BLOCK), buf_w.reshape(n_blocks, MOE_BLOCK), block_e))
    return jnp.zeros_like(u).at[buf_tok].add(ys.reshape(cap, D))


def hybrid_layer(x, c_act, ada_w, ada_b, norm1_g, w_in, q_norm_g, k_norm_g, rel_bias_table,
                 conv_w, conv_b, dt_bias, a_log, d_skip, ssm_norm_g, w_attn_branch, w_ssm_branch,
                 gate_bias, w_out, norm2_g, router_w, router_b, expert_w1, expert_b1, expert_w2, expert_b2):
    Bsz, S, D = x.shape
    mod = c_act @ ada_w + ada_b
    shift1, scale1, gate1, shift2, scale2, gate2 = (m[:, None, :] for m in jnp.split(mod, 6, axis=-1))
    u = rms_norm(x, norm1_g) * (1.0 + scale1) + shift1
    proj = jnp.einsum('bsd,de->bse', u, w_in)
    c0 = 3 * ATTN_WIDTH
    cuts = [ATTN_WIDTH, 2 * ATTN_WIDTH, c0, c0 + SSM_INNER, c0 + SSM_INNER + SSM_CONV_DIM,
            c0 + SSM_INNER + SSM_CONV_DIM + SSM_HEADS]
    q, k, v, z, xbc, dt_raw, gate_logits = jnp.split(proj, cuts, axis=-1)
    heads = (Bsz, S, ATTN_HEADS, ATTN_HEAD_DIM)
    q = rms_norm(q.reshape(heads), q_norm_g)
    k = rms_norm(k.reshape(heads), k_norm_g)
    v = v.reshape(heads)
    attn = lax.map(lambda qkv: moba_attention_single(qkv[0], qkv[1], qkv[2], rel_bias_table), (q, k, v))
    attn = attn.reshape(Bsz, S, ATTN_WIDTH)
    ssm = mamba2_branch(z, xbc, dt_raw, conv_w, conv_b, dt_bias, a_log, d_skip, ssm_norm_g)
    gate_attn, gate_ssm = jnp.split(jax.nn.sigmoid(gate_logits + gate_bias), 2, axis=-1)
    merged = gate_attn * (attn @ w_attn_branch) + gate_ssm * (ssm @ w_ssm_branch)
    x = x + gate1 * (merged @ w_out)
    u2 = rms_norm(x, norm2_g) * (1.0 + scale2) + shift2
    ffn = moe_ffn(u2.reshape(Bsz * S, D), router_w, router_b, expert_w1, expert_b1, expert_w2, expert_b2)
    return x + gate2 * ffn.reshape(Bsz, S, D)


def setup_inputs(seed: int = 0) -> dict:
    key = jax.random.key(seed)
    ks = jax.random.split(key, 32)
    f32 = jnp.float32

    def nrm(k, shape, s):
        return jax.random.normal(k, shape, f32) * s

    L = DEPTH
    dt0 = jnp.exp(jax.random.uniform(ks[11], (L, SSM_HEADS), f32) * (math.log(0.1) - math.log(0.001)) + math.log(0.001))
    return {
        'x': nrm(ks[0], (BATCH, SEQ, D_MODEL), 1.0),
        'c': nrm(ks[1], (BATCH, D_MODEL), 1.0),
        'ada_w': nrm(ks[2], (L, D_MODEL, 6 * D_MODEL), D_MODEL ** -0.5),
        'ada_b': nrm(ks[3], (L, 6 * D_MODEL), 0.02),
        'norm1_g': 1.0 + nrm(ks[4], (L, D_MODEL), 0.02),
        'w_in': nrm(ks[5], (L, D_MODEL, IN_PROJ_DIM), D_MODEL ** -0.5),
        'q_norm_g': 1.0 + nrm(ks[6], (L, ATTN_HEAD_DIM), 0.02),
        'k_norm_g': 1.0 + nrm(ks[7], (L, ATTN_HEAD_DIM), 0.02),
        'rel_bias_table': nrm(ks[8], (REL_BUCKETS, ATTN_HEADS), 0.2),
        'conv_w': nrm(ks[9], (L, SSM_CONV, SSM_CONV_DIM), SSM_CONV ** -0.5),
        'conv_b': nrm(ks[10], (L, SSM_CONV_DIM), 0.02),
        'dt_bias': dt0 + jnp.log(-jnp.expm1(-dt0)),
        'a_log': jnp.log(jax.random.uniform(ks[12], (L, SSM_HEADS), f32, minval=1.0, maxval=16.0)),
        'd_skip': 1.0 + nrm(ks[13], (L, SSM_HEADS), 0.02),
        'ssm_norm_g': 1.0 + nrm(ks[14], (L, SSM_INNER), 0.02),
        'w_attn_branch': nrm(ks[15], (L, ATTN_WIDTH, D_MODEL), ATTN_WIDTH ** -0.5),
        'w_ssm_branch': nrm(ks[16], (L, SSM_INNER, D_MODEL), SSM_INNER ** -0.5),
        'gate_bias': nrm(ks[17], (L, N_BRANCHES * D_MODEL), 0.02),
        'w_out': nrm(ks[18], (L, D_MODEL, D_MODEL), D_MODEL ** -0.5),
        'norm2_g': 1.0 + nrm(ks[19], (L, D_MODEL), 0.02),
        'router_w': nrm(ks[20], (L, D_MODEL, N_EXPERTS), D_MODEL ** -0.5),
        'router_b': nrm(ks[21], (L, N_EXPERTS), 0.01),
        'expert_w1': nrm(ks[22], (L, N_EXPERTS, D_MODEL, 2 * EXPERT_FF), D_MODEL ** -0.5),
        'expert_b1': nrm(ks[23], (L, N_EXPERTS, 2 * EXPERT_FF), 0.01),
        'expert_w2': nrm(ks[24], (L, N_EXPERTS, EXPERT_FF, D_MODEL), EXPERT_FF ** -0.5),
        'expert_b2': nrm(ks[25], (L, N_EXPERTS, D_MODEL), 0.01),
    }


def reference(x, c, ada_w, ada_b, norm1_g, w_in, q_norm_g, k_norm_g, rel_bias_table, conv_w, conv_b,
              dt_bias, a_log, d_skip, ssm_norm_g, w_attn_branch, w_ssm_branch, gate_bias, w_out, norm2_g,
              router_w, router_b, expert_w1, expert_b1, expert_w2, expert_b2):
    c_act = jax.nn.silu(c)
    h = x
    for l in range(DEPTH):
        h = hybrid_layer(h, c_act, ada_w[l], ada_b[l], norm1_g[l], w_in[l], q_norm_g[l], k_norm_g[l],
                         rel_bias_table, conv_w[l], conv_b[l], dt_bias[l], a_log[l], d_skip[l],
                         ssm_norm_g[l], w_attn_branch[l], w_ssm_branch[l], gate_bias[l], w_out[l],
                         norm2_g[l], router_w[l], router_b[l], expert_w1[l], expert_b1[l],
                         expert_w2[l], expert_b2[l])
    return h
```

```cpp
#include <hip/hip_runtime.h>
#include <cstdint>
#include <cstdio>

typedef unsigned short bf16;
typedef short bf16x8 __attribute__((ext_vector_type(8)));
typedef float f32x4 __attribute__((ext_vector_type(4)));

constexpr int D = 1024, NBATCH = 16, SEQ = 2048, T = NBATCH * SEQ;
constexpr int NH = 16, HD = 64;
constexpr int SI = 2048, SH = 32, SP = 64, SG = 4, SN = 128, CONVD = 3072;
constexpr int NE = 32, FF = 1024;
constexpr int NPROJ = 10272, NPROJ_PAD = 10496;
constexpr int CATP = 3072;
constexpr int LISTCAP = 32768;
constexpr int MOE_ROWS = 4 * T + NE * 256;
constexpr float EPS = 1e-6f;
constexpr float LOG2E = 1.4426950408889634f;
constexpr float QSCALE = 0.125f * LOG2E;

constexpr size_t MiB = 1u << 20;
constexpr size_t OFF_CTL = 0;
constexpr size_t OFF_MOD = 1 * MiB;
constexpr size_t OFF_RELB = 1 * MiB + 512 * 1024;
constexpr size_t OFF_KMEAN = 2 * MiB;
constexpr size_t OFF_TOPKW = 3 * MiB + 512 * 1024;
constexpr size_t OFF_LIST = 4 * MiB;
constexpr size_t OFF_DTRAW = 8 * MiB;
constexpr size_t OFF_SSQ = 20 * MiB;
constexpr size_t OFF_RST = 16 * MiB;
constexpr size_t OFF_WIN = 24 * MiB;
constexpr size_t OFF_WA = 45 * MiB, OFF_WS = 47 * MiB, OFF_WO = 51 * MiB;
constexpr size_t OFF_W1 = 54 * MiB;
constexpr size_t OFF_W2 = 182 * MiB;
constexpr size_t OFF_U = 246 * MiB;
constexpr size_t OFF_CAT = 310 * MiB;
constexpr size_t OFF_K = 502 * MiB;
constexpr size_t OFF_V = 566 * MiB;
constexpr size_t OFF_XS = 630 * MiB;
constexpr size_t OFF_BR = 758 * MiB, OFF_CR = 790 * MiB;
constexpr size_t OFF_GATES = 822 * MiB;
constexpr size_t OFF_CB = 950 * MiB;
constexpr size_t OFF_U2 = 246 * MiB;
constexpr size_t OFF_HB = 310 * MiB;
constexpr size_t OFF_YB = 582 * MiB;
constexpr size_t WS_NEED = 982 * MiB;
constexpr int CW_COUNTS = 1024;
constexpr int CW_TILEBASE = 1088;

__device__ __forceinline__ float bf2f(bf16 v) { return __uint_as_float(((unsigned)v) << 16); }
__device__ __forceinline__ bf16 f2bf(float f) { unsigned u = __float_as_uint(f); return (bf16)((u + 0x7fffu + ((u >> 16) & 1u)) >> 16); }
__device__ __forceinline__ float siluf(float x) { return x / (1.f + __expf(-x)); }
__device__ __forceinline__ float sigm(float x) { return 1.f / (1.f + __expf(-x)); }
__device__ __forceinline__ float wave_sum(float v) {
#pragma unroll
    for (int o = 1; o < 64; o <<= 1) v += __shfl_xor(v, o);
    return v;
}
__device__ __forceinline__ float wave_max(float v) {
#pragma unroll
    for (int o = 1; o < 64; o <<= 1) v = fmaxf(v, __shfl_xor(v, o));
    return v;
}
__device__ __forceinline__ float softplusf(float x) { return x > 20.f ? x : log1pf(__expf(x)); }
__device__ __forceinline__ float silu_fast(float x) { return x * __builtin_amdgcn_rcpf(1.f + __builtin_amdgcn_exp2f(-LOG2E * x)); }
__device__ __forceinline__ float softplus_fast(float x) { const float t = __builtin_amdgcn_exp2f(LOG2E * x); return x > 20.f ? x : (t < 1e-3f ? t * (1.f - 0.5f * t) : 0.6931471805599453f * __builtin_amdgcn_logf(1.f + t)); }

__host__ __device__ __forceinline__ int win_logical(int n) {
    if (n >= NPROJ) return -1;
    const int tile = n >> 8;
    if (tile < 8) { const int l = n & 255, bj = (l >> 7) & 1, wc = (l >> 5) & 3, j = l & 31; return tile * 256 + 64 * wc + 32 * bj + j; }
    if (n < 8192) return n;
    if (n < 10240) return n + 32;
    return n - 2048;
}
__host__ __device__ __forceinline__ int w1_logical(int n) { const int pn = n >> 8, bj = (n >> 7) & 1, j = n & 127; return bj * 1024 + pn * 128 + j; }

constexpr int NWAVES = 8;
constexpr int RING_BYTES = 131072, TAB_OFF = RING_BYTES, TAB_BYTES = 24576, LCTL_OFF = TAB_OFF + TAB_BYTES, LDS_BYTES = 163840;
__device__ __forceinline__ int hw_wave_slot() { return (int)__builtin_amdgcn_s_getreg((5 << 11) | 4) & 63; }
__device__ __forceinline__ int lane_id() { return (int)__builtin_amdgcn_mbcnt_hi(~0u, __builtin_amdgcn_mbcnt_lo(~0u, 0u)); }
__device__ __forceinline__ int wave_idx() { extern __shared__ __attribute__((aligned(16))) unsigned char lds_raw_[]; return __builtin_amdgcn_readfirstlane(((volatile __attribute__((address_space(3))) int*)((__attribute__((address_space(3))) unsigned char*)lds_raw_ + LCTL_OFF))[192 + hw_wave_slot()]); }
__device__ __forceinline__ int tidx() { return wave_idx() * 64 + lane_id(); }

#define LAS __attribute__((address_space(3)))
#define GAS __attribute__((address_space(1)))
typedef unsigned u32x4 __attribute__((ext_vector_type(4)));
typedef unsigned u32x2 __attribute__((ext_vector_type(2)));
namespace pg8 {
constexpr int BM = 256, BK = 64, HALF = 128, HTB = HALF * BK * 2, STAGE_BYTES = 8 * HTB, NXCD = 8;
__host__ __device__ __forceinline__ int lds_byte(int r, int c) { const int st = (r >> 4) * 2 + (c >> 5), rr = r & 15, cc = c & 31, ob = rr * 64 + cc * 2; return st * 1024 + (ob ^ (((ob >> 9) & 1) << 5)); }
__host__ __device__ __forceinline__ void stage_rc(int b, int& R, int& C) { const int st = b / 1024, sb = b % 1024, swz = sb ^ (((sb >> 9) & 1) << 5); R = (st >> 1) * 16 + swz / 64; C = (st & 1) * 32 + (swz % 64) / 2; }
__host__ __device__ __forceinline__ int perm32(int rho) { const int n = rho >> 4, i = rho & 15; return 8 * (i >> 2) + 4 * n + (i & 3); }

struct Unit { int pm, pn, e; const char* a; const char* b; };
struct Gemm { const char* A; int lda, ldb, K; };

__device__ __forceinline__ void order_map(int L, int nM, int nN, int WGM, int& pm, int& pn) {
    const int nwg = nM * nN; int wgid = L;
    { const int q = nwg / NXCD, r = nwg % NXCD, xcd = wgid % NXCD, off = wgid / NXCD; wgid = (xcd < r ? xcd * (q + 1) : r * (q + 1) + (xcd - r) * q) + off; }
    const int nig = WGM * nN, gid = wgid / nig, fm = gid * WGM, gsz = (nM - fm) < WGM ? (nM - fm) : WGM;
    pm = fm + ((wgid % nig) % gsz); pn = (wgid % nig) / gsz;
}
struct StaticOrder {
    int nM, nN, nwg, G, c, wgm; const char* A; const char* B; size_t atile, btile;
    __device__ __forceinline__ void init(int M, int N, int G_, int c_, const void* A_, int lda, const void* B_, int ldb, int wgm_) { wgm = wgm_; nM = M / BM; nN = N / BM; nwg = nM * nN; G = G_; c = c_; A = (const char*)A_; B = (const char*)B_; atile = (size_t)BM * lda * 2; btile = (size_t)BM * ldb * 2; }
    __device__ __forceinline__ bool next(int i, Unit& u) const {
        const long L = (long)i * G + c; if (L >= nwg) return false;
        order_map((int)L, nM, nN, wgm, u.pm, u.pn); u.e = 0; u.a = A + (size_t)u.pm * atile; u.b = B + (size_t)u.pn * btile; return true;
    }
};
struct MoeOrder {
    int nM, nN, nwg, G, c, wgm; const volatile LAS int* tb; const char* A; const char* B; size_t atile, btile, estride;
    __device__ __forceinline__ void init(const volatile LAS int* tb_, int N, int G_, int c_, const void* A_, int lda, const void* B_, int ldb, size_t estride_, int wgm_) { wgm = wgm_;
        tb = tb_; nM = tb_[NE]; nN = N / BM; nwg = nM * nN; G = G_; c = c_; A = (const char*)A_; B = (const char*)B_; atile = (size_t)BM * lda * 2; btile = (size_t)BM * ldb * 2; estride = estride_; }
    __device__ __forceinline__ bool next(int i, Unit& u) const {
        const long L = (long)i * G + c; if (L >= nwg) return false;
        order_map((int)L, nM, nN, wgm, u.pm, u.pn);
        int e = 0;
        for (int k = 1; k < NE; ++k) e += (tb[k] <= u.pm) ? 1 : 0;
        u.e = __builtin_amdgcn_readfirstlane(e); u.a = A + (size_t)u.pm * atile; u.b = B + (size_t)u.e * estride + (size_t)u.pn * btile; return true;
    }
};

__device__ __forceinline__ unsigned cvt_pk_bf16(float lo, float hi) { unsigned r; asm volatile("v_cvt_pk_bf16_f32 %0, %1, %2" : "=v"(r) : "v"(lo), "v"(hi)); return r; }

template <class Epi, class Sched, bool GATHER>
__device__ __forceinline__ void gemm_phase(LAS unsigned char* lds, const Gemm g, const Sched& S, const Epi& E, const LAS unsigned* tab) {
    const int tid = tidx(), wid = __builtin_amdgcn_readfirstlane(tid >> 6), lane = tid & 63, wr = wid >> 2, wc = wid & 3, fr = lane & 15, fq = lane >> 4;
    const int K = g.K, nt = K / BK;
    unsigned voffA[2], voffB[2]; int R0, C0;
    { int R, C; stage_rc(tid * 16, R, C); R0 = R; C0 = C; }
#pragma unroll
    for (int i = 0; i < 2; ++i) { int R, C; stage_rc(tid * 16 + i * 8192, R, C); const int Rb = (R & ~31) + perm32(R & 31);
        voffA[i] = (unsigned)(R * g.lda + C) * 2u; voffB[i] = (unsigned)(Rb * g.ldb + C) * 2u; }
    const size_t kstep = (size_t)(BK * 2);
    const size_t hstepA = (size_t)HALF * g.lda * 2, hstepB = (size_t)HALF * g.ldb * 2;
    const unsigned ldsw = (unsigned)wid * 1024u;
    const int aoff = lds_byte(wr * 64 + fr, fq * 8), boff = lds_byte(wc * 32 + fr, fq * 8);
#define PG8_SA(b, h) (((b) * 2 + (h)) * HTB)
#define PG8_SB(b, h) ((4 + (b) * 2 + (h)) * HTB)
#define PG8_STAGE(bufoff, gbase, voff) do { _Pragma("unroll") for (int _i = 0; _i < 2; ++_i) \
        __builtin_amdgcn_global_load_lds((const unsigned*)((const char*)(gbase) + (voff)[_i]), (LAS unsigned*)(lds + (bufoff) + ldsw + _i * 8192), 16, 0, 0); } while (0)
#define PG8_STA(bufoff, kb, h, nx) do { if constexpr (GATHER) { unsigned _v[2]; _v[0] = (nx) ? gn[h][0] : gc[h][0]; _v[1] = (nx) ? gn[h][1] : gc[h][1]; PG8_STAGE(bufoff, g.A + (kb), _v); } \
        else { PG8_STAGE(bufoff, ((nx) ? nA : cA) + (kb) + (h) * hstepA, voffA); } } while (0)
#define PG8_LDA(dst, b, h) do { _Pragma("unroll") for (int m = 0; m < 4; ++m) _Pragma("unroll") for (int k = 0; k < 2; ++k) dst[m][k] = *(const LAS bf16x8*)(lds + PG8_SA(b, h) + aoff + m * 2048 + k * 1024); } while (0)
#define PG8_LDB(dst, b, h) do { _Pragma("unroll") for (int n = 0; n < 2; ++n) _Pragma("unroll") for (int k = 0; k < 2; ++k) dst[n][k] = *(const LAS bf16x8*)(lds + PG8_SB(b, h) + boff + n * 2048 + k * 1024); } while (0)
#define PG8_MMA(ai, bj, At, Bt) do { __builtin_amdgcn_s_setprio(1); _Pragma("unroll") for (int m = 0; m < 4; ++m) _Pragma("unroll") for (int n = 0; n < 2; ++n) _Pragma("unroll") for (int k = 0; k < 2; ++k) \
        acc[ai][bj][m][n] = __builtin_amdgcn_mfma_f32_16x16x32_bf16(Bt[n][k], At[m][k], acc[ai][bj][m][n], 0, 0, 0); __builtin_amdgcn_s_setprio(0); } while (0)
#define PG8_WAIT_V(n) asm volatile("s_waitcnt vmcnt(" #n ")" ::: "memory")
#define PG8_WAIT_L(n) asm volatile("s_waitcnt lgkmcnt(" #n ")" ::: "memory")
#define PG8_BAR __builtin_amdgcn_s_barrier()
#define PG8_SCHED __builtin_amdgcn_sched_barrier(0)
#define PG8_GOFF(dst, uidx) do { _Pragma("unroll") for (int h = 0; h < 2; ++h) _Pragma("unroll") for (int i = 0; i < 2; ++i) dst[h][i] = tab[(uidx) * 256 + h * 128 + i * 64 + R0] + (unsigned)(C0 * 2); } while (0)
    Unit cur, nxt; int ui = 0;
    if (!S.next(0, cur)) return;
    f32x4 acc[2][2][4][2];
#pragma unroll
    for (int a = 0; a < 2; ++a)
#pragma unroll
        for (int b = 0; b < 2; ++b)
#pragma unroll
            for (int m = 0; m < 4; ++m)
#pragma unroll
                for (int n = 0; n < 2; ++n) acc[a][b][m][n] = (f32x4){0.f, 0.f, 0.f, 0.f};
    bf16x8 At[4][2], B0[2][2], B1[2][2];
    const char* cA = cur.a; const char* cB = cur.b; const char* nA = cA;
    unsigned gc[2][2] = {{0u, 0u}, {0u, 0u}}, gn[2][2] = {{0u, 0u}, {0u, 0u}};
    if constexpr (GATHER) { PG8_GOFF(gc, 0); }
    PG8_STAGE(PG8_SB(0, 0), cB, voffB); PG8_STAGE(PG8_SB(0, 1), cB + hstepB, voffB); PG8_STA(PG8_SA(0, 0), 0, 0, false); PG8_STA(PG8_SA(0, 1), 0, 1, false);
    if (wr == 1) PG8_BAR;
    PG8_WAIT_V(2); PG8_BAR;
    PG8_STAGE(PG8_SB(1, 0), cB + kstep, voffB); PG8_STA(PG8_SA(1, 0), kstep, 0, false); PG8_STAGE(PG8_SB(1, 1), cB + hstepB + kstep, voffB);
    PG8_WAIT_V(6); PG8_BAR;
    for (;;) {
        const bool has_next = S.next(ui + 1, nxt);
        nA = has_next ? nxt.a : cA; const char* nB = has_next ? nxt.b : cB;
        if constexpr (GATHER) { if (has_next) { PG8_GOFF(gn, ui + 1); } else {
#pragma unroll
            for (int h = 0; h < 2; ++h) { gn[h][0] = gc[h][0]; gn[h][1] = gc[h][1]; } } }
        for (int t = 0; t < nt; t += 2) {
            if constexpr (Epi::HOOKS) { if (t == 8 || t == 16 || t == 24) E.hook(acc, cur, t, wr, fr); }
            const bool last = (t == nt - 2);
            const size_t k1 = (size_t)(t + 1) * kstep, k2 = last ? 0 : (size_t)(t + 2) * kstep, k3 = k2 + kstep;
            const char* b2 = last ? nB : cB + (size_t)(t + 2) * kstep; const char* b3 = b2 + kstep;
            PG8_LDB(B0, 0, 0); PG8_LDB(B1, 0, 1); PG8_SCHED; PG8_LDA(At, 0, 0); PG8_STA(PG8_SA(1, 1), k1, 1, false);
            PG8_WAIT_V(8); PG8_WAIT_L(0); PG8_BAR; PG8_MMA(0, 0, At, B0); PG8_MMA(0, 1, At, B1); PG8_BAR; PG8_SCHED;
            PG8_LDA(At, 0, 1); PG8_STAGE(PG8_SB(0, 0), b2, voffB); PG8_STAGE(PG8_SB(0, 1), b2 + hstepB, voffB); PG8_STA(PG8_SA(0, 0), k2, 0, last);
            PG8_WAIT_V(8); PG8_WAIT_L(0); PG8_BAR; PG8_MMA(1, 0, At, B0); PG8_MMA(1, 1, At, B1); PG8_BAR; PG8_SCHED;
            PG8_LDB(B0, 1, 0); PG8_LDB(B1, 1, 1); PG8_SCHED; PG8_LDA(At, 1, 0); PG8_STA(PG8_SA(0, 1), k2, 1, last);
            PG8_WAIT_V(8); PG8_WAIT_L(0); PG8_BAR; PG8_MMA(0, 0, At, B0); PG8_MMA(0, 1, At, B1); PG8_BAR; PG8_SCHED;
            PG8_LDA(At, 1, 1); PG8_STAGE(PG8_SB(1, 0), b3, voffB); PG8_STAGE(PG8_SB(1, 1), b3 + hstepB, voffB); PG8_STA(PG8_SA(1, 0), k3, 0, last);
            PG8_WAIT_V(8); PG8_WAIT_L(0); PG8_BAR; PG8_MMA(1, 0, At, B0); PG8_MMA(1, 1, At, B1); PG8_BAR; PG8_SCHED;
        }
        if (wr == 0) PG8_BAR;
        E(acc, cur, ui, wr, wc, fr, fq);
        if (!has_next) break;
#pragma unroll
        for (int a = 0; a < 2; ++a)
#pragma unroll
            for (int b = 0; b < 2; ++b)
#pragma unroll
                for (int m = 0; m < 4; ++m)
#pragma unroll
                    for (int n = 0; n < 2; ++n) acc[a][b][m][n] = (f32x4){0.f, 0.f, 0.f, 0.f};
        cur = nxt; cA = nA; cB = nB; ++ui;
        if constexpr (GATHER) {
#pragma unroll
            for (int h = 0; h < 2; ++h) { gc[h][0] = gn[h][0]; gc[h][1] = gn[h][1]; } }
        if (wr == 1) PG8_BAR;
    }
    PG8_WAIT_V(0);
    PG8_BAR;
#undef PG8_SA
#undef PG8_SB
#undef PG8_STAGE
#undef PG8_STA
#undef PG8_LDA
#undef PG8_LDB
#undef PG8_MMA
#undef PG8_WAIT_V
#undef PG8_WAIT_L
#undef PG8_BAR
#undef PG8_SCHED
#undef PG8_GOFF
}
}
namespace epi {
using pg8::Unit; using pg8::cvt_pk_bf16;
__device__ __forceinline__ u32x4 pack8(const f32x4& a, const f32x4& b) { u32x4 w; w.x = cvt_pk_bf16(a[0], a[1]); w.y = cvt_pk_bf16(a[2], a[3]); w.z = cvt_pk_bf16(b[0], b[1]); w.w = cvt_pk_bf16(b[2], b[3]); return w; }
__device__ __forceinline__ void unpack8(const u32x4& w, f32x4& a, f32x4& b) {
    a[0] = __uint_as_float(w.x << 16); a[1] = __uint_as_float(w.x & 0xffff0000u); a[2] = __uint_as_float(w.y << 16); a[3] = __uint_as_float(w.y & 0xffff0000u);
    b[0] = __uint_as_float(w.z << 16); b[1] = __uint_as_float(w.z & 0xffff0000u); b[2] = __uint_as_float(w.w << 16); b[3] = __uint_as_float(w.w & 0xffff0000u); }
typedef float f32x2_t __attribute__((ext_vector_type(2)));
__device__ __forceinline__ f32x4 sigm4(const f32x4& x) { f32x4 r; r[0] = sigm(x[0]); r[1] = sigm(x[1]); r[2] = sigm(x[2]); r[3] = sigm(x[3]); return r; }

struct EpiInProj { static constexpr bool HOOKS = false;
    unsigned char* wsb; const float *qg, *kg; float* kmean;
    __device__ __forceinline__ void operator()(const f32x4 (&acc)[2][2][4][2], const Unit& u, int ui, int wr, int wc, int fr, int fq) const {
        bf16* cat = (bf16*)(wsb + OFF_CAT); bf16* kb = (bf16*)(wsb + OFF_K); bf16* vb = (bf16*)(wsb + OFF_V); bf16* xs = (bf16*)(wsb + OFF_XS); bf16* brw = (bf16*)(wsb + OFF_BR); bf16* crw = (bf16*)(wsb + OFF_CR);
        bf16* gates = (bf16*)(wsb + OFF_GATES); float* dtraw = (float*)(wsb + OFF_DTRAW);
        const int pn = u.pn; const int row0 = u.pm * 256 + wr * 64 + fr;
        if (pn < 8) {
            const bool isq = pn < 4; const float* g = isq ? qg : kg; const float sc = isq ? QSCALE : 1.f;
            f32x4 gv[2][2], ks[2][2];
#pragma unroll
            for (int bj = 0; bj < 2; ++bj)
#pragma unroll
                for (int n = 0; n < 2; ++n) { gv[bj][n] = *(const f32x4*)(g + 32 * bj + 8 * fq + 4 * n) * sc; ks[bj][n] = (f32x4){0.f, 0.f, 0.f, 0.f}; }
            bf16* base = isq ? cat + (pn * 256 + 64 * wc + 8 * fq) : kb + ((pn - 4) * 256 + 64 * wc + 8 * fq); const size_t pitch = isq ? CATP : D;
#pragma unroll
            for (int ai = 0; ai < 2; ++ai)
#pragma unroll
                for (int m = 0; m < 4; ++m) {
                    float s = 0.f;
#pragma unroll
                    for (int bj = 0; bj < 2; ++bj)
#pragma unroll
                        for (int n = 0; n < 2; ++n) { const f32x4 x = acc[ai][bj][m][n]; s += (x[0] * x[0] + x[1] * x[1]) + (x[2] * x[2] + x[3] * x[3]); }
                    s += __shfl_xor(s, 16); s += __shfl_xor(s, 32);
                    const float rs = rsqrtf(s * (1.f / 64.f) + EPS);
                    bf16* rowp = isq ? base + (size_t)(row0 + ai * 128 + m * 16) * pitch
                                     : kb + ((size_t)((((u.pm >> 3) * 16 + (pn - 4) * 4 + wc) * 32 + ((u.pm * 4 + wr + 2 * ai) & 31)) * 4096 + fq * 512 + (fr + 16 * m) * 8));
                    const int bjs = isq ? 32 : 2048;
#pragma unroll
                    for (int bj = 0; bj < 2; ++bj) { const f32x4 o0 = acc[ai][bj][m][0] * rs * gv[bj][0], o1 = acc[ai][bj][m][1] * rs * gv[bj][1];
                        *(u32x4*)(rowp + bjs * bj) = pack8(o0, o1); ks[bj][0] += o0; ks[bj][1] += o1; }
                }
            if (!isq) {
                float* km = kmean + ((size_t)u.pm * NH + (pn - 4) * 4 + wc) * 64 + 8 * fq;
#pragma unroll
                for (int bj = 0; bj < 2; ++bj)
#pragma unroll
                    for (int n = 0; n < 2; ++n)
#pragma unroll
                        for (int e = 0; e < 4; ++e) { float v = ks[bj][n][e]; v += __shfl_xor(v, 1); v += __shfl_xor(v, 2); v += __shfl_xor(v, 4); v += __shfl_xor(v, 8);
                            if (fr == 0) atomicAdd(km + 32 * bj + 4 * n + e, v * (1.f / 256.f)); }
            }
        } else if (pn < 12) {
#pragma unroll
            for (int ai = 0; ai < 2; ++ai)
#pragma unroll
                for (int m = 0; m < 4; ++m)
#pragma unroll
                    for (int bj = 0; bj < 2; ++bj) {
                        bf16* p = vb + ((size_t)((((u.pm >> 3) * 16 + (pn - 8) * 4 + 2 * bj + (wc >> 1)) * 32 + ((u.pm * 4 + wr + 2 * ai) & 31)) * 4096 + ((wc & 1) * 4 + m) * 512 + fr * 32 + 8 * fq));
                        __builtin_nontemporal_store(pack8(acc[ai][bj][m][0], acc[ai][bj][m][1]), (u32x4*)p); }
        } else if (pn < 40) {
            bf16* base; size_t pitch;
            if (pn < 20) { base = cat + 1024 + (pn - 12) * 256; pitch = CATP; }
            else if (pn < 28) { base = xs + (pn - 20) * 256; pitch = SI; }
            else if (pn < 30) { base = brw + (pn - 28) * 256; pitch = 512; }
            else if (pn < 32) { base = crw + (pn - 30) * 256; pitch = 512; }
            else { base = gates + (pn - 32) * 256; pitch = 2048; }
            base += wc * 32 + 8 * fq;
#pragma unroll
            for (int ai = 0; ai < 2; ++ai)
#pragma unroll
                for (int m = 0; m < 4; ++m) { bf16* rowp = base + (size_t)(row0 + ai * 128 + m * 16) * pitch;
#pragma unroll
                    for (int bj = 0; bj < 2; ++bj) __builtin_nontemporal_store(pack8(acc[ai][bj][m][0], acc[ai][bj][m][1]), (u32x4*)(rowp + bj * 128)); }
        } else if (wc == 0) {
#pragma unroll
            for (int ai = 0; ai < 2; ++ai)
#pragma unroll
                for (int m = 0; m < 4; ++m) { float* p = dtraw + (size_t)(row0 + ai * 128 + m * 16) * 32 + 8 * fq; *(f32x4*)p = acc[ai][0][m][0]; *(f32x4*)(p + 4) = acc[ai][0][m][1]; }
        }
    }
};
struct EpiMergedA { static constexpr bool HOOKS = false;
    unsigned char* wsb; const float* gb;
    __device__ __forceinline__ void operator()(const f32x4 (&acc)[2][2][4][2], const Unit& u, int ui, int wr, int wc, int fr, int fq) const {
        const bf16* gates = (const bf16*)(wsb + OFF_GATES); bf16* out = (bf16*)(wsb + OFF_K); const float* ssq = (const float*)(wsb + OFF_SSQ); float* rst = (float*)(wsb + OFF_RST);
        const int row0 = u.pm * 256 + wr * 64 + fr, col0 = u.pn * 256 + wc * 32 + 8 * fq;
        f32x2_t rso; { const int tid = tidx(); const size_t r = (size_t)u.pm * 256 + (tid & 255); const int g2 = (tid >> 8) * 2; const float* sp = ssq + r * 32 + 8 * g2;
          const f32x4 a = *(const f32x4*)(sp), b = *(const f32x4*)(sp + 4), c = *(const f32x4*)(sp + 8), d = *(const f32x4*)(sp + 12);
          rso.x = rsqrtf(((a[0] + a[1]) + (a[2] + a[3]) + (b[0] + b[1]) + (b[2] + b[3])) * (1.f / 512.f) + EPS); rso.y = rsqrtf(((c[0] + c[1]) + (c[2] + c[3]) + (d[0] + d[1]) + (d[2] + d[3])) * (1.f / 512.f) + EPS); }
        f32x4 bv[2][2];
#pragma unroll
        for (int bj = 0; bj < 2; ++bj) { bv[bj][0] = *(const f32x4*)(gb + col0 + bj * 128); bv[bj][1] = *(const f32x4*)(gb + col0 + bj * 128 + 4); }
#pragma unroll
        for (int ai = 0; ai < 2; ++ai) {
            u32x4 gq[4][2];
#pragma unroll
            for (int m = 0; m < 4; ++m)
#pragma unroll
                for (int bj = 0; bj < 2; ++bj) gq[m][bj] = *(const u32x4*)(gates + (size_t)(row0 + ai * 128 + m * 16) * 2048 + col0 + bj * 128);
#pragma unroll
            for (int m = 0; m < 4; ++m)
#pragma unroll
                for (int bj = 0; bj < 2; ++bj) { f32x4 g0, g1; unpack8(gq[m][bj], g0, g1);
                    *(u32x4*)(out + (size_t)(row0 + ai * 128 + m * 16) * D + col0 + bj * 128) = pack8(sigm4(g0 + bv[bj][0]) * acc[ai][bj][m][0], sigm4(g1 + bv[bj][1]) * acc[ai][bj][m][1]); }
        }
        { const int tid = tidx(); const size_t r = (size_t)u.pm * 256 + (tid & 255); const int g2 = (tid >> 8) * 2; *(f32x2_t*)(rst + ((size_t)u.pn * T + r) * 4 + g2) = rso; }
    }
};
struct EpiMergedB {
    static constexpr bool HOOKS = true;
    unsigned char* wsb; const float* gb;
    __device__ __forceinline__ void hook(f32x4 (&acc)[2][2][4][2], const Unit& u, int t, int wr, int fr) const {
        const float* rst = (const float*)(wsb + OFF_RST);
        const int g = (t >> 3) - 1;
#pragma unroll
        for (int ai = 0; ai < 2; ++ai)
#pragma unroll
            for (int m = 0; m < 4; ++m) { const size_t r = (size_t)(u.pm * 256 + wr * 64 + fr + ai * 128 + m * 16); const f32x4 rs = *(const f32x4*)(rst + ((size_t)u.pn * T + r) * 4);
                const float f = g == 0 ? rs[0] / rs[1] : (g == 1 ? rs[1] / rs[2] : rs[2] / rs[3]);
#pragma unroll
                for (int bj = 0; bj < 2; ++bj) { acc[ai][bj][m][0] *= f; acc[ai][bj][m][1] *= f; }
                if (m & 1) asm volatile("" ::: "memory"); }
    }
    __device__ __forceinline__ void operator()(const f32x4 (&acc)[2][2][4][2], const Unit& u, int ui, int wr, int wc, int fr, int fq) const {
        const bf16* gates = (const bf16*)(wsb + OFF_GATES); bf16* out = (bf16*)(wsb + OFF_K); const float* rst = (const float*)(wsb + OFF_RST);
        const int row0 = u.pm * 256 + wr * 64 + fr, col0 = u.pn * 256 + wc * 32 + 8 * fq;
        f32x4 bv[2][2];
#pragma unroll
        for (int bj = 0; bj < 2; ++bj) { bv[bj][0] = *(const f32x4*)(gb + 1024 + col0 + bj * 128); bv[bj][1] = *(const f32x4*)(gb + 1024 + col0 + bj * 128 + 4); }
#pragma unroll
        for (int ai = 0; ai < 2; ++ai)
#pragma unroll
          for (int mh = 0; mh < 4; mh += 2) {
            u32x4 gq[2][2], tq[2][2]; float r3[2];
#pragma unroll
            for (int m = 0; m < 2; ++m) { const size_t r = (size_t)(row0 + ai * 128 + (mh + m) * 16); r3[m] = rst[((size_t)u.pn * T + r) * 4 + 3];
#pragma unroll
                for (int bj = 0; bj < 2; ++bj) { gq[m][bj] = *(const u32x4*)(gates + r * 2048 + 1024 + col0 + bj * 128); tq[m][bj] = *(const u32x4*)(out + r * D + col0 + bj * 128); } }
#pragma unroll
            for (int m = 0; m < 2; ++m) { const size_t r = (size_t)(row0 + ai * 128 + (mh + m) * 16);
#pragma unroll
                for (int bj = 0; bj < 2; ++bj) { f32x4 g0, g1, t0, t1; unpack8(gq[m][bj], g0, g1); unpack8(tq[m][bj], t0, t1);
                    *(u32x4*)(out + r * D + col0 + bj * 128) = pack8(t0 + sigm4(g0 + bv[bj][0]) * r3[m] * acc[ai][bj][mh + m][0], t1 + sigm4(g1 + bv[bj][1]) * r3[m] * acc[ai][bj][mh + m][1]); } }
            asm volatile("" ::: "memory");
          }
    }
};
struct EpiOut { static constexpr bool HOOKS = false;
    const float* x; const float* mod; float* out;
    __device__ __forceinline__ void operator()(const f32x4 (&acc)[2][2][4][2], const Unit& u, int ui, int wr, int wc, int fr, int fq) const {
        const int row0 = u.pm * 256 + wr * 64 + fr, col0 = u.pn * 256 + wc * 32 + 8 * fq; const float* g1 = mod + (u.pm >> 3) * 6144 + 2 * D;
        f32x4 gv[2][2];
#pragma unroll
        for (int bj = 0; bj < 2; ++bj) { gv[bj][0] = *(const f32x4*)(g1 + col0 + bj * 128); gv[bj][1] = *(const f32x4*)(g1 + col0 + bj * 128 + 4); }
#pragma unroll
        for (int ai = 0; ai < 2; ++ai) {
            f32x4 xv[4][2][2];
#pragma unroll
            for (int m = 0; m < 4; ++m)
#pragma unroll
                for (int bj = 0; bj < 2; ++bj) { const size_t o = (size_t)(row0 + ai * 128 + m * 16) * D + col0 + bj * 128; xv[m][bj][0] = *(const f32x4*)(x + o); xv[m][bj][1] = *(const f32x4*)(x + o + 4); }
#pragma unroll
            for (int m = 0; m < 4; ++m)
#pragma unroll
                for (int bj = 0; bj < 2; ++bj) { const size_t o = (size_t)(row0 + ai * 128 + m * 16) * D + col0 + bj * 128;
                    *(f32x4*)(out + o) = xv[m][bj][0] + gv[bj][0] * acc[ai][bj][m][0]; *(f32x4*)(out + o + 4) = xv[m][bj][1] + gv[bj][1] * acc[ai][bj][m][1]; }
        }
    }
};
__device__ __forceinline__ f32x4 swiglu4(f32x4 g, f32x4 l) { f32x4 r;
#pragma unroll
    for (int i = 0; i < 4; ++i) { const float gg = fminf(g[i], 7.f), ll = fminf(fmaxf(l[i], -7.f), 7.f); r[i] = gg * sigm(1.702f * gg) * (ll + 1.f); } return r; }
struct EpiMoe1 { static constexpr bool HOOKS = false;
    const float* b1; bf16* hb;
    __device__ __forceinline__ void operator()(const f32x4 (&acc)[2][2][4][2], const Unit& u, int ui, int wr, int wc, int fr, int fq) const {
        const int j0 = u.pn * 128 + wc * 32 + 8 * fq; const float* bb = b1 + u.e * 2048 + j0;
        const f32x4 bg0 = *(const f32x4*)(bb), bg1 = *(const f32x4*)(bb + 4), bl0 = *(const f32x4*)(bb + 1024), bl1 = *(const f32x4*)(bb + 1028);
#pragma unroll
        for (int ai = 0; ai < 2; ++ai)
#pragma unroll
            for (int m = 0; m < 4; ++m) { const size_t r = (size_t)u.pm * 256 + ai * 128 + wr * 64 + m * 16 + fr;
                *(u32x4*)(hb + r * FF + j0) = pack8(swiglu4(acc[ai][0][m][0] + bg0, acc[ai][1][m][0] + bl0), swiglu4(acc[ai][0][m][1] + bg1, acc[ai][1][m][1] + bl1)); }
    }
};
struct EpiMoe2 { static constexpr bool HOOKS = false;
    const float* b2; bf16* yb; const LAS int* tabE; const LAS float* tabW;
    __device__ __forceinline__ void operator()(const f32x4 (&acc)[2][2][4][2], const Unit& u, int ui, int wr, int wc, int fr, int fq) const {
        const int col0 = u.pn * 256 + wc * 32 + 8 * fq; const float* bb = b2 + u.e * D + col0;
        f32x4 bv[2][2];
#pragma unroll
        for (int bj = 0; bj < 2; ++bj) { bv[bj][0] = *(const f32x4*)(bb + bj * 128); bv[bj][1] = *(const f32x4*)(bb + bj * 128 + 4); }
#pragma unroll
        for (int ai = 0; ai < 2; ++ai)
#pragma unroll
            for (int m = 0; m < 4; ++m) { const int r = ui * 256 + ai * 128 + wr * 64 + m * 16 + fr; const int ent = tabE[r]; const float w = tabW[r];
                if (ent >= 0) { bf16* p = yb + (size_t)ent * D + col0;
#pragma unroll
                    for (int bj = 0; bj < 2; ++bj) *(u32x4*)(p + bj * 128) = pack8((acc[ai][bj][m][0] + bv[bj][0]) * w, (acc[ai][bj][m][1] + bv[bj][1]) * w); } }
    }
};
}

namespace attn_body {
using bf16=unsigned short;
using bf16x8=__attribute__((ext_vector_type(8)))short;
using s16x4=__attribute__((ext_vector_type(4)))short;
using f32x16=__attribute__((ext_vector_type(16)))float;
constexpr int BATCH=16,NHEAD=16,SEQ=2048,D=64,DM=NHEAD*D,QP=3072;
constexpr int NW=8,QBLK=32,QB=QBLK*NW,KVBLK=64,NQB=SEQ/QB;
constexpr int ATTN_UNIT_ROWS=QB;
constexpr int YOFF=2063, TARR=2384, TARRB=TARR*4, TBL_BYTES=4*TARRB+256;
__device__ __forceinline__ int crow(int r,int hi){return (r&3)+8*(r>>2)+4*hi;}
#define SBAR() __builtin_amdgcn_sched_barrier(0)
__device__ __forceinline__ void cmask(f32x16&p0,f32x16&p1,int jb,int qrel,int hi){
  const float NEG=-INFINITY; const int lim=qrel-4*hi-64*jb;
  #pragma unroll
  for(int r=0;r<16;++r){const int c=(r&3)+8*(r>>2); if(c>lim)p0[r]=NEG; if(c+32>lim)p1[r]=NEG;}
}

constexpr int NSLOT=3, SLOTB=8192;
constexpr int LDS_K=0, LDS_V=NSLOT*SLOTB, LDS_WS=2*NSLOT*SLOTB, LDS_OST=LDS_WS+NW*64*4, LDS_TBL=LDS_OST+NW*4096, LDS_BYTES=LDS_TBL+TBL_BYTES;
__device__ __forceinline__ void glds16(const void*gsrc,unsigned lds_dst){unsigned keep;
  asm volatile("s_mov_b32 %0, m0\n\ts_mov_b32 m0, %2\n\ts_nop 0\n\tglobal_load_lds_dwordx4 %1, off\n\ts_mov_b32 m0, %0":"=&s"(keep):"v"(gsrc),"s"(lds_dst):"memory");}
__device__ __forceinline__ float max3f(float a,float b,float c){float r;asm("v_max3_f32 %0, %1, %2, %3":"=v"(r):"v"(a),"v"(b),"v"(c));return r;}
__device__ __forceinline__ float max2f(float a,float b){float r;asm("v_max_f32_e32 %0, %1, %2":"=v"(r):"v"(a),"v"(b));return r;}
__device__ __forceinline__ float fadd_s(float a,float b){float r;asm("v_add_f32_e32 %0, %1, %2":"=v"(r):"v"(a),"v"(b));return r;}
__device__ __forceinline__ float fsub_s(float a,float b){float r;asm("v_sub_f32_e32 %0, %1, %2":"=v"(r):"v"(a),"v"(b));return r;}
typedef float f32x2_t __attribute__((ext_vector_type(2))); typedef __bf16 bf16x2_t __attribute__((ext_vector_type(2)));
__device__ __forceinline__ unsigned cvtpk_s(float lo,float hi){f32x2_t v={lo,hi};bf16x2_t b=__builtin_convertvector(v,bf16x2_t);return __builtin_bit_cast(unsigned,b);}
#define WAIT_BAR(N) asm volatile("s_waitcnt vmcnt(" #N ") lgkmcnt(0)\n\ts_barrier":::"memory")

__device__ __forceinline__ void qkt(f32x16&p0,f32x16&p1,const char*Kslot,const bf16x8*qr,int r32,int hi){
  const char*kb=Kslot+hi*1024+r32*16;
  #pragma unroll
  for(int d0=0;d0<4;++d0){
    const bf16x8 b0=*reinterpret_cast<const bf16x8*>(kb+d0*2048);
    const bf16x8 b1=*reinterpret_cast<const bf16x8*>(kb+d0*2048+512);
    p0=__builtin_amdgcn_mfma_f32_32x32x16_bf16(b0,qr[d0],p0,0,0,0);p1=__builtin_amdgcn_mfma_f32_32x32x16_bf16(b1,qr[d0],p1,0,0,0);}
}
typedef __attribute__((address_space(3))) const char* lds_cptr;
typedef short v4i16_t __attribute__((ext_vector_type(4)));
__device__ __forceinline__ void kload8(bf16x8*kf,lds_cptr kp){
  kf[0]=*(const __attribute__((address_space(3))) bf16x8*)(kp);      kf[1]=*(const __attribute__((address_space(3))) bf16x8*)(kp+512);
  kf[2]=*(const __attribute__((address_space(3))) bf16x8*)(kp+2048); kf[3]=*(const __attribute__((address_space(3))) bf16x8*)(kp+2560);
  kf[4]=*(const __attribute__((address_space(3))) bf16x8*)(kp+4096); kf[5]=*(const __attribute__((address_space(3))) bf16x8*)(kp+4608);
  kf[6]=*(const __attribute__((address_space(3))) bf16x8*)(kp+6144); kf[7]=*(const __attribute__((address_space(3))) bf16x8*)(kp+6656);
}
__device__ __forceinline__ void kload2(bf16x8*kf,lds_cptr kp,int j){ kf[2*j]=*(const __attribute__((address_space(3))) bf16x8*)(kp+j*2048); kf[2*j+1]=*(const __attribute__((address_space(3))) bf16x8*)(kp+j*2048+512); }
__device__ __forceinline__ s16x4 vtr(lds_cptr p){ return __builtin_bit_cast(s16x4,__builtin_amdgcn_ds_read_tr16_b64_v4i16((__attribute__((address_space(3))) v4i16_t*)p)); }
__device__ __forceinline__ float rowmax(const f32x16&p0,const f32x16&p1){
  float a=max3f(p0[0],p0[1],p1[0]),b=max3f(p0[2],p0[3],p1[1]);a=max3f(a,p1[2],p1[3]);
  #pragma unroll
  for(int r=4;r<16;r+=4){a=max3f(a,p0[r],p0[r+1]);b=max3f(b,p0[r+2],p0[r+3]);a=max3f(a,p1[r],p1[r+1]);b=max3f(b,p1[r+2],p1[r+3]);}
  const float m=max2f(a,b);
  auto rr=__builtin_amdgcn_permlane32_swap(__float_as_uint(m),__float_as_uint(m),false,false);
  return max2f(__uint_as_float(rr[0]),__uint_as_float(rr[1]));
}
__device__ __forceinline__ void pv(f32x16*o,int vb,bf16x8 pa0,bf16x8 pa1,bf16x8 pa2,bf16x8 pa3){
  #pragma unroll
  for(int d0=0;d0<2;++d0){s16x4 lo[4],hi[4];
    #pragma unroll
    for(int ks=0;ks<4;++ks){
      asm volatile("ds_read_b64_tr_b16 %0,%1 offset:%c2":"=&v"(lo[ks]):"v"(vb),"i"(d0*4096+ks*1024):"memory");
      asm volatile("ds_read_b64_tr_b16 %0,%1 offset:%c2":"=&v"(hi[ks]):"v"(vb),"i"(d0*4096+ks*1024+512):"memory");}
    asm volatile("s_waitcnt lgkmcnt(0)":::"memory");SBAR();
    #define PK(k) (bf16x8){lo[k][0],lo[k][1],lo[k][2],lo[k][3],hi[k][0],hi[k][1],hi[k][2],hi[k][3]}
    o[d0]=__builtin_amdgcn_mfma_f32_32x32x16_bf16(pa0,PK(0),o[d0],0,0,0);
    o[d0]=__builtin_amdgcn_mfma_f32_32x32x16_bf16(pa1,PK(1),o[d0],0,0,0);
    o[d0]=__builtin_amdgcn_mfma_f32_32x32x16_bf16(pa2,PK(2),o[d0],0,0,0);
    o[d0]=__builtin_amdgcn_mfma_f32_32x32x16_bf16(pa3,PK(3),o[d0],0,0,0);
    #undef PK
  }
}

#ifndef ATTN_STORE16
#define ATTN_STORE16(p,v) (*(u32x4*)(p)=(v))
#endif
template<int THRL> __device__ __forceinline__ void attn_unit(int b,int h,int qb,const bf16*Q,const bf16*__restrict__ K,const bf16*__restrict__ V,bf16*O,const float*__restrict__ kmean,char*shm){
  const int tid=tidx(),lane=tid&63,r32=lane&31,hi=lane>>5; const int wid=__builtin_amdgcn_readfirstlane(tid>>6);
  const long rowbase=(long)b*SEQ; const int q0=qb*QB;
  const bf16*Qw=Q+(rowbase+q0+wid*QBLK)*QP+h*D;
  const bf16*Kh=K+(long)((b*NHEAD+h)*32)*4096,*Vh=V+(long)((b*NHEAD+h)*32)*4096;
  const unsigned lds0=(unsigned)(uintptr_t)shm;
  float*wsf=(float*)(shm+LDS_WS)+wid*64;
  const bf16*ksrc=Kh+(wid*64+lane)*8;
  const bf16*vsrc=Vh+(wid*64+lane)*8;
  const unsigned kdst=lds0+LDS_K+wid*1024, vdst=lds0+LDS_V+wid*1024;
  #define TMAP(t) (((t)<4)?(4*qb+(t)):((t)-4))
  #define DMA_K(t,slot) glds16(ksrc+(long)TMAP(t)*4096,(unsigned)__builtin_amdgcn_readfirstlane(kdst+(slot)))
  #define DMA_V(t,slot) glds16(vsrc+(long)TMAP(t)*4096,(unsigned)__builtin_amdgcn_readfirstlane(vdst+(slot)))
  const int vb0=(int)(lds0+LDS_V)+((lane>>4)&1)*32+(lane&3)*8+(4*hi+((lane&15)>>2))*64;
  const char*Kbase=shm+LDS_K; bf16x8 kf[8];
  const lds_cptr shm3=(lds_cptr)shm; const lds_cptr kp0=shm3+LDS_K+hi*1024+r32*16; const lds_cptr vp0=shm3+LDS_V+((lane>>4)&1)*32+(lane&3)*8+(4*hi+((lane&15)>>2))*64;
  const int NT=(q0+QB)/KVBLK;
  DMA_K(0,0);DMA_V(0,0);DMA_K(1,SLOTB);
  bf16x8 qr[4];
  #pragma unroll
  for(int d0=0;d0<4;++d0)qr[d0]=*reinterpret_cast<const bf16x8*>(&Qw[(long)r32*QP+d0*16+hi*8]);
  float mhat=0.f,l_reg=0.f;f32x16 o[2];o[0]=f32x16{};o[1]=f32x16{};
  const int qrel=wid*QBLK+r32;
  unsigned selm=0u;
  { f32x16 gacc=f32x16{};
    if(qb>0){ const float*kmn=kmean+(long)r32*NHEAD*D; asm volatile("":"+v"(kmn));
      #pragma unroll
      for(int d0=0;d0<4;++d0){ f32x4 k0={0.f,0.f,0.f,0.f},k1={0.f,0.f,0.f,0.f};
        if(r32<qb){ k0=*reinterpret_cast<const f32x4*>(kmn+d0*16+hi*8); k1=*reinterpret_cast<const f32x4*>(kmn+d0*16+hi*8+4); }
        u32x4 uh,ul; float h0,h1;
        uh.x=cvtpk_s(k0[0],k0[1]); h0=__uint_as_float(uh.x<<16); h1=__uint_as_float(uh.x&0xffff0000u); ul.x=cvtpk_s(k0[0]-h0,k0[1]-h1);
        uh.y=cvtpk_s(k0[2],k0[3]); h0=__uint_as_float(uh.y<<16); h1=__uint_as_float(uh.y&0xffff0000u); ul.y=cvtpk_s(k0[2]-h0,k0[3]-h1);
        uh.z=cvtpk_s(k1[0],k1[1]); h0=__uint_as_float(uh.z<<16); h1=__uint_as_float(uh.z&0xffff0000u); ul.z=cvtpk_s(k1[0]-h0,k1[1]-h1);
        uh.w=cvtpk_s(k1[2],k1[3]); h0=__uint_as_float(uh.w<<16); h1=__uint_as_float(uh.w&0xffff0000u); ul.w=cvtpk_s(k1[2]-h0,k1[3]-h1);
        gacc=__builtin_amdgcn_mfma_f32_32x32x16_bf16(__builtin_bit_cast(bf16x8,uh),qr[d0],gacc,0,0,0);
        gacc=__builtin_amdgcn_mfma_f32_32x32x16_bf16(__builtin_bit_cast(bf16x8,ul),qr[d0],gacc,0,0,0); } }
    float gt[8];
    #pragma unroll
    for(int i=0;i<4;++i){ const float own=gacc[i], oth=__shfl_xor(own,32); gt[i]=hi?oth:own; gt[4+i]=hi?own:oth; }
    #pragma unroll
    for(int n=0;n<8;++n) if(n>=qb) gt[n]=-INFINITY;
    #pragma unroll
    for(int n=0;n<8;++n){ int rk=0;
      #pragma unroll
      for(int m=0;m<8;++m) rk+=(m<qb&&(gt[m]>gt[n]||(gt[m]==gt[n]&&m<n)))?1:0;
      if(n<qb&&(qb<=3||rk<3)) selm|=(1u<<n); } }
  const int qabs=q0+qrel, cpy=(YOFF-qabs)&3;
  const lds_cptr tb_sel=shm3+(LDS_TBL+cpy*TARRB+4*(YOFF-qabs+4*hi-cpy)), tb_neg=shm3+(LDS_TBL+4*TARRB);
  typedef __attribute__((address_space(3))) const f32x4* lds_f4p;
  #define BIASLD(P0,P1,t) do{ const int tt_=TMAP(t); const bool on_=((t)<4)||((selm>>(tt_>>2))&1u); const lds_cptr ba_=on_?(tb_sel+256*tt_):tb_neg; \
    _Pragma("unroll") for(int g_=0;g_<4;++g_){ const f32x4 x0_=*(lds_f4p)(ba_+32*g_), x1_=*(lds_f4p)(ba_+32*g_+128); \
      _Pragma("unroll") for(int i_=0;i_<4;++i_){ P0[4*g_+i_]=x0_[i_]-mhat; P1[4*g_+i_]=x1_[i_]-mhat; } } }while(0)
  #define CMASK(P0,P1,t) do{ if((t)<4){ int qr_=qrel; asm volatile("":"+v"(qr_)); cmask(P0,P1,(t),qr_,hi); } }while(0)
  bool resc=false;
  #define START(P0,P1) do{ const float rm=rowmax(P0,P1); resc=false; \
    { const float dl=rm; mhat=fadd_s(mhat,dl); \
      _Pragma("unroll") for(int r=0;r<16;++r){P0[r]=fsub_s(P0[r],dl);P1[r]=fsub_s(P1[r],dl);} } \
    _Pragma("unroll") for(int r=0;r<16;++r)P0[r]=__builtin_amdgcn_exp2f(P0[r]); }while(0)
  #define RESC() do{ if(resc){ asm volatile("s_waitcnt lgkmcnt(0)":::"memory"); \
      _Pragma("unroll") for(int d_=0;d_<2;++d_) _Pragma("unroll") for(int r=0;r<16;++r)o[d_][r]*=wsf[crow(r,hi)]; } }while(0)
  f32x16 pA0,pA1,pB0,pB1;
  int sl_prev=0,sl_cur=0,sl_next=SLOTB;
  #define ROT() do{sl_prev=sl_cur;sl_cur=sl_next;sl_next=(sl_next==(NSLOT-1)*SLOTB)?0:sl_next+SLOTB;}while(0)
  DMA_K(2,2*SLOTB);
  WAIT_BAR(3);
  BIASLD(pA0,pA1,0); qkt(pA0,pA1,Kbase,qr,r32,hi);asm volatile("s_nop 15\n\ts_nop 7":"+v"(pA0),"+v"(pA1));CMASK(pA0,pA1,0);
  START(pA0,pA1);
  _Pragma("unroll") for(int r=0;r<16;++r)pA1[r]=__builtin_amdgcn_exp2f(pA1[r]);
  WAIT_BAR(0);
  DMA_K(3,0);DMA_V(1,SLOTB);
  ROT();
  kload8(kf,kp0+sl_cur);
  WAIT_BAR(2);
  s16x4 vlo[8],vhi[8]; u32x4 pw0,pw1,pw2,pw3;
  #define PKW(P,B) cvtpk_s(P[B],P[B+1])
  #define PAF(k) __builtin_bit_cast(bf16x8,pw##k)
  #define VFR(i) (bf16x8){vlo[i][0],vlo[i][1],vlo[i][2],vlo[i][3],vhi[i][0],vhi[i][1],vhi[i][2],vhi[i][3]}
  #define PIN(x) asm volatile("":"+v"(x))
  #define MX3(a,b,c) __builtin_fmaxf(__builtin_fmaxf((a),(b)),(c))
  #define GAPA(MF,A0,A1,A2,A3,W0,W1,PW) do{ MF; sacc+=A0; sacc+=A1; sacc+=A2; sacc+=A3; PIN(sacc); W0; W1; PIN(PW); SBAR(); }while(0)
  #define EX(v) __builtin_amdgcn_exp2f(v)
  #define GAPB(MF,X,B) do{ MF; X[B]=EX(X[B]); X[B+1]=EX(X[B+1]); X[B+2]=EX(X[B+2]); X[B+3]=EX(X[B+3]); PIN(X); SBAR(); }while(0)
  #define VRD(i) do{ vlo[i]=vtr(vp_+(((i)>>2)*4096+((i)&3)*1024)); vhi[i]=vtr(vp_+(((i)>>2)*4096+((i)&3)*1024+512)); }while(0)
  #define KRD(G,j) do{ if(G){ kload2(kf,kp0+sl_next,j); SBAR(); } }while(0)
  #define STEP(C0,C1,P0,P1,t,GK,GV,GL) do{ SBAR(); \
    BIASLD(C0,C1,t); SBAR(); \
    const lds_cptr vp_=vp0+sl_prev; \
    VRD(0); SBAR(); float sacc=(P0[0]+P0[1]); \
    GAPA(C0=__builtin_amdgcn_mfma_f32_32x32x16_bf16(kf[0],qr[0],C0,0,0,0), P0[2],P0[3],P0[4],P0[5],     pw0[0]=PKW(P0,0), pw0[1]=PKW(P0,2), pw0); \
    VRD(4); SBAR(); GAPA(C1=__builtin_amdgcn_mfma_f32_32x32x16_bf16(kf[1],qr[0],C1,0,0,0), P0[6],P0[7],P0[8],P0[9],     pw0[2]=PKW(P0,4), pw0[3]=PKW(P0,6), pw0); \
    VRD(1); SBAR(); GAPA(C0=__builtin_amdgcn_mfma_f32_32x32x16_bf16(kf[2],qr[1],C0,0,0,0),   P0[10],P0[11],P0[12],P0[13], pw1[0]=PKW(P0,8), pw1[1]=PKW(P0,10), pw1); \
    VRD(5); SBAR(); GAPA(C1=__builtin_amdgcn_mfma_f32_32x32x16_bf16(kf[3],qr[1],C1,0,0,0),   P0[14],P0[15],P1[0],P1[1],   pw1[2]=PKW(P0,12),pw1[3]=PKW(P0,14), pw1); \
    VRD(2); SBAR(); GAPA(C0=__builtin_amdgcn_mfma_f32_32x32x16_bf16(kf[4],qr[2],C0,0,0,0),   P1[2],P1[3],P1[4],P1[5],     pw2[0]=PKW(P1,0), pw2[1]=PKW(P1,2), pw2); \
    VRD(6); SBAR(); GAPA(C1=__builtin_amdgcn_mfma_f32_32x32x16_bf16(kf[5],qr[2],C1,0,0,0),   P1[6],P1[7],P1[8],P1[9],     pw2[2]=PKW(P1,4), pw2[3]=PKW(P1,6), pw2); \
    VRD(3); SBAR(); GAPA(C0=__builtin_amdgcn_mfma_f32_32x32x16_bf16(kf[6],qr[3],C0,0,0,0),   P1[10],P1[11],P1[12],P1[13], pw3[0]=PKW(P1,8), pw3[1]=PKW(P1,10), pw3); \
    VRD(7); SBAR(); GAPA(C1=__builtin_amdgcn_mfma_f32_32x32x16_bf16(kf[7],qr[3],C1,0,0,0),   P1[14],P1[15],0.f,0.f,       pw3[2]=PKW(P1,12),pw3[3]=PKW(P1,14), pw3); \
    l_reg+=sacc; \
    if(GK){DMA_K((t)+3,sl_cur);} if(GV){DMA_V((t)+1,sl_next);} \
    CMASK(C0,C1,t); \
    { float a=MX3(C0[0],C0[1],C1[0]),b=MX3(C0[2],C0[3],C1[1]); a=MX3(a,C1[2],C1[3]); \
      _Pragma("unroll") for(int r=4;r<16;r+=4){a=MX3(a,C0[r],C0[r+1]);b=MX3(b,C0[r+2],C0[r+3]);a=MX3(a,C1[r],C1[r+1]);b=MX3(b,C1[r+2],C1[r+3]);} \
      float rm=__builtin_fmaxf(a,b); { auto rr=__builtin_amdgcn_permlane32_swap(__float_as_uint(rm),__float_as_uint(rm),false,false); rm=__builtin_fmaxf(__uint_as_float(rr[0]),__uint_as_float(rr[1])); } \
      resc=false; \
      if(__builtin_expect(__any(rm>(float)THRL),0)){ const float dl=__builtin_fmaxf(rm,0.f); mhat+=dl; \
        _Pragma("unroll") for(int r=0;r<16;++r){C0[r]-=dl;C1[r]-=dl;} \
        const float f=__builtin_amdgcn_exp2f(-dl); l_reg*=f; if(hi==0)wsf[r32]=f; resc=true; } } \
    SBAR(); \
    GAPB(o[0]=__builtin_amdgcn_mfma_f32_32x32x16_bf16(PAF(0),VFR(0),o[0],0,0,0), C0,0); \
    GAPB(o[1]=__builtin_amdgcn_mfma_f32_32x32x16_bf16(PAF(0),VFR(4),o[1],0,0,0), C0,4); \
    KRD(GL,0); GAPB(o[0]=__builtin_amdgcn_mfma_f32_32x32x16_bf16(PAF(1),VFR(1),o[0],0,0,0), C0,8); \
    KRD(GL,1); GAPB(o[1]=__builtin_amdgcn_mfma_f32_32x32x16_bf16(PAF(1),VFR(5),o[1],0,0,0), C0,12); \
    KRD(GL,2); GAPB(o[0]=__builtin_amdgcn_mfma_f32_32x32x16_bf16(PAF(2),VFR(2),o[0],0,0,0), C1,0); \
    KRD(GL,3); GAPB(o[1]=__builtin_amdgcn_mfma_f32_32x32x16_bf16(PAF(2),VFR(6),o[1],0,0,0), C1,4); \
    GAPB(o[0]=__builtin_amdgcn_mfma_f32_32x32x16_bf16(PAF(3),VFR(3),o[0],0,0,0), C1,8); \
    GAPB(o[1]=__builtin_amdgcn_mfma_f32_32x32x16_bf16(PAF(3),VFR(7),o[1],0,0,0), C1,12); \
    }while(0)
  int t=1;
  for(;t+5<NT;t+=2){
    STEP(pB0,pB1,pA0,pA1,t,true,true,true);     WAIT_BAR(2); RESC(); ROT();
    STEP(pA0,pA1,pB0,pB1,t+1,true,true,true);   WAIT_BAR(2); RESC(); ROT();
  }
  #define ENDW(tt) do{ if((tt)+3<NT){WAIT_BAR(2);} else if((tt)+2<NT){WAIT_BAR(1);} else {WAIT_BAR(0);} }while(0)
  for(;t+1<NT;t+=2){
    STEP(pB0,pB1,pA0,pA1,t,(t+3<NT),(t+1<NT),(t+1<NT));       ENDW(t);   RESC(); ROT();
    STEP(pA0,pA1,pB0,pB1,t+1,(t+4<NT),(t+2<NT),(t+2<NT));     ENDW(t+1); RESC(); ROT();
  }
  STEP(pB0,pB1,pA0,pA1,NT-1,false,false,false); RESC();
  { float sacc=pB0[0]+pB0[1]; _Pragma("unroll") for(int r=2;r<16;++r)sacc+=pB0[r]; _Pragma("unroll") for(int r=0;r<16;++r)sacc+=pB1[r]; l_reg+=sacc;
    pw0=(u32x4){PKW(pB0,0),PKW(pB0,2),PKW(pB0,4),PKW(pB0,6)};pw1=(u32x4){PKW(pB0,8),PKW(pB0,10),PKW(pB0,12),PKW(pB0,14)};pw2=(u32x4){PKW(pB1,0),PKW(pB1,2),PKW(pB1,4),PKW(pB1,6)};pw3=(u32x4){PKW(pB1,8),PKW(pB1,10),PKW(pB1,12),PKW(pB1,14)};
    SBAR(); pv(o,vb0+sl_cur,PAF(0),PAF(1),PAF(2),PAF(3)); }
  #undef PKW
  #undef PAF
  #undef VFR
  #undef PIN
  #undef MX3
  #undef GAPA
  #undef GAPB
  #undef EX
  #undef VRD
  #undef KRD
  #undef STEP
  #undef ENDW
  {auto rr=__builtin_amdgcn_permlane32_swap(__float_as_uint(l_reg),__float_as_uint(l_reg),false,false);l_reg=__uint_as_float(rr[0])+__uint_as_float(rr[1]);}
  if(hi==0)wsf[32+r32]=l_reg;asm volatile("s_waitcnt lgkmcnt(0)":::"memory");
  float rli[16];
  #pragma unroll
  for(int r=0;r<16;++r)rli[r]=__builtin_amdgcn_rcpf(wsf[32+crow(r,hi)]);
  bf16*Ow=O+(rowbase+q0+wid*QBLK)*QP+h*D;
  { bf16*stg=(bf16*)(shm+LDS_OST)+wid*2048;
    #pragma unroll
    for(int r=0;r<16;++r){const int orow=crow(r,hi);
      #pragma unroll
      for(int d0=0;d0<2;++d0)stg[orow*64+d0*32+r32]=(bf16)(cvtpk_s(o[d0][r]*rli[r],0.f)&0xffffu);}
    asm volatile("s_waitcnt lgkmcnt(0)":::"memory");
    #pragma unroll
    for(int i=0;i<4;++i){const int row=i*8+(lane>>3),ch=lane&7; const u32x4 v=*(const u32x4*)(stg+row*64+ch*8); ATTN_STORE16(Ow+(long)row*QP+ch*8,v);} }
  asm volatile("s_waitcnt lgkmcnt(0)\n\ts_barrier":::"memory");
  #undef DMA_K
  #undef DMA_V
  #undef TMAP
  #undef BIASLD
  #undef CMASK
  #undef START
  #undef RESC
  #undef ROT
}
constexpr int ATTN_LDS_BYTES=LDS_BYTES;
__device__ __forceinline__ void fill_tables(char*shm,const float*__restrict__ relb){
  float*tb=(float*)(shm+LDS_TBL);
  for(int i=tidx();i<4*TARR+64;i+=512){ const int c=i/TARR, z=i-c*TARR, d=YOFF-z-c; tb[i]=(c==4)?-INFINITY:((d>=0&&d<SEQ)?relb[d]:0.f); }
}
#undef SBAR
#undef WAIT_BAR
}

namespace ssd {
typedef float f32x16 __attribute__((ext_vector_type(16)));
typedef LAS unsigned char* lptr;
constexpr int LCH = 128, NCH = SEQ / LCH;
constexpr int ROWB = 272;
constexpr size_t TILE_E = 128 * 128;
__device__ __forceinline__ int crow(int r, int hi) { return (r & 3) + 8 * (r >> 2) + 4 * hi; }
__device__ __forceinline__ unsigned pk(float lo, float hi) { return pg8::cvt_pk_bf16(lo, hi); }
__device__ __forceinline__ float bflo(unsigned w) { return __uint_as_float(w << 16); }
__device__ __forceinline__ float bfhi(unsigned w) { return __uint_as_float(w & 0xffff0000u); }

__device__ __forceinline__ void pre_unit(int unit, lptr lds, const bf16* __restrict__ brw, const bf16* __restrict__ crw, const float* __restrict__ conv_w, const float* __restrict__ conv_b,
                                         bf16* __restrict__ CBm, bf16* __restrict__ Ccg, bf16* __restrict__ BcT) {
    const int tid = tidx(), lane = tid & 63, wv = __builtin_amdgcn_readfirstlane(tid >> 6);
    const int g = unit & 3, c = (unit >> 2) & 15, b = unit >> 6;
    const size_t tbase = (size_t)unit * TILE_E;
    lptr CcL = lds, BcL = lds + 128 * ROWB;
    {
        const int arr = tid >> 8, n = tid & 127, lh = (tid >> 7) & 1;
        const bf16* src = (arr ? crw : brw) + (size_t)(b * SEQ + c * LCH) * 512 + g * 128 + n;
        const int chn = (arr ? 2560 : 2048) + g * 128 + n;
        const float w0 = conv_w[chn], w1 = conv_w[CONVD + chn], w2 = conv_w[2 * CONVD + chn], w3 = conv_w[3 * CONVD + chn], cb = conv_b[chn];
        const int l0 = lh * 64; const bool has_prev = (c > 0) || (lh > 0);
        float h0 = has_prev ? bf2f(src[(long)(l0 - 3) * 512]) : 0.f, h1 = has_prev ? bf2f(src[(long)(l0 - 2) * 512]) : 0.f, h2 = has_prev ? bf2f(src[(long)(l0 - 1) * 512]) : 0.f;
        lptr dstL = (arr ? CcL : BcL) + n * 2;
#pragma unroll 1
        for (int l8 = 0; l8 < 64; l8 += 8) {
            float v[8];
#pragma unroll
            for (int i = 0; i < 8; ++i) { const float cur = bf2f(src[(long)(l0 + l8 + i) * 512]); v[i] = siluf(cb + w0 * h0 + w1 * h1 + w2 * h2 + w3 * cur); h0 = h1; h1 = h2; h2 = cur; }
            unsigned pw[4];
#pragma unroll
            for (int i = 0; i < 4; ++i) pw[i] = pk(v[2 * i], v[2 * i + 1]);
#pragma unroll
            for (int i = 0; i < 8; ++i) *(LAS unsigned short*)(dstL + (l0 + l8 + i) * ROWB) = (unsigned short)((i & 1) ? (pw[i >> 1] >> 16) : (pw[i >> 1] & 0xffffu));
            if (arr) {
#pragma unroll
                for (int i = 0; i < 8; ++i) { const int l = l0 + l8 + i, t = n & 15;
                    Ccg[tbase + ((size_t)(((l >> 5) * 8 + (n >> 4)) * 64 + (l & 31) + 32 * ((t >> 2) & 1))) * 8 + (((t >> 3) << 2) | (t & 3))] = (bf16)((i & 1) ? (pw[i >> 1] >> 16) : (pw[i >> 1] & 0xffffu)); }
            } else { u32x4 o; o.x = pw[0]; o.y = pw[1]; o.z = pw[2]; o.w = pw[3]; const int l = l0 + l8;
                *(u32x4*)(BcT + tbase + ((size_t)(((n >> 5) * 8 + (l >> 4)) * 64 + (n & 31) + 32 * ((l >> 3) & 1))) * 8) = o; }
        }
    }
    __syncthreads();
    {
        const int r32 = lane & 31, hi = lane >> 5, rt = wv >> 1;
#pragma unroll
        for (int cc = 0; cc < 2; ++cc) {
            const int ct = 2 * (wv & 1) + cc;
            if (ct <= rt) {
                f32x16 acc = {};
#pragma unroll
                for (int ks = 0; ks < 8; ++ks) {
                    const bf16x8 a = *(const LAS bf16x8*)(CcL + (32 * rt + r32) * ROWB + (16 * ks + 8 * hi) * 2);
                    const bf16x8 bb = *(const LAS bf16x8*)(BcL + (32 * ct + r32) * ROWB + (16 * ks + 8 * hi) * 2);
                    acc = __builtin_amdgcn_mfma_f32_32x32x16_bf16(a, bb, acc, 0, 0, 0);
                }
#pragma unroll
                for (int r = 0; r < 16; ++r) { const int s = 32 * ct + r32;
                    CBm[tbase + ((size_t)((rt * 8 + (s >> 4)) * 64 + crow(r, hi) + 32 * ((s >> 3) & 1))) * 8 + (s & 7)] = f2bf(acc[r]); }
            }
        }
    }
    __syncthreads();
}

constexpr int U_XS = 0, U_ST = 64 * ROWB, STP = 136, U_HF = 2 * 64 * ROWB, U_SC = U_HF + 2 * 16384, U_BYTES = U_SC + 2 * 1536;

__device__ __forceinline__ void main_pair(int bh, lptr lds_wg, const bf16* __restrict__ cat, bf16* __restrict__ yout, float* __restrict__ ssq, const bf16* __restrict__ xs, const float* __restrict__ dtraw, const bf16* __restrict__ CBm, const bf16* __restrict__ Ccg, const bf16* __restrict__ BcT,
                                          const float* __restrict__ conv_w, const float* __restrict__ conv_b, const float* __restrict__ dt_bias, const float* __restrict__ a_log, const float* __restrict__ d_skip) {
    const int tid = tidx(), lane = tid & 63, wave = __builtin_amdgcn_readfirstlane(tid >> 6), w = wave & 3, un = wave >> 2, lt = tid & 255;
    const int r32 = lane & 31, hi = lane >> 5;
    const int h = bh & 31, b = bh >> 5, g = h >> 3;
    lptr L = lds_wg + un * U_BYTES;
    const float A2 = -__expf(a_log[h]) * LOG2E, dtb = dt_bias[h], dsk = d_skip[h];
    const int cp = lt & 63;
    f32x16 Hs[2]; Hs[0] = f32x16{}; Hs[1] = f32x16{};
    const int oR = (32 * w + (lane >> 3)) * CATP + h * 64 + 8 * (lane & 7), oX = (32 * w - 3) * SI + h * 64 + cp;
    float dr0 = 0.f, dr1 = 0.f;
#define SSD_PREF(cn) do { const size_t t0_ = (size_t)b * SEQ + (size_t)(cn) * LCH; if (w == 0) { dr0 = dtraw[(t0_ + 2 * lane) * 32 + h]; dr1 = dtraw[(t0_ + 2 * lane + 1) * 32 + h]; } } while (0)
    SSD_PREF(0);
    if (un == 1) __syncthreads();
    for (int c = 0; c < NCH; ++c) {
        const size_t tok0 = (size_t)b * SEQ + (size_t)c * LCH;
        const size_t tbase = ((size_t)(b * NCH + c) * 4 + g) * TILE_E;
        LAS float* SC = (LAS float*)(L + U_SC + (c & 1) * 1536);
        u32x4 cbf[8]; u32x2 ccf[16]; u32x4 zq[4]; unsigned short rawx[35];
        const float* cwp = conv_w + h * 64; const float* cbp_ = conv_b + h * 64; asm volatile("" : "+s"(cwp), "+s"(cbp_));
        const float cw0 = cwp[cp], cw1 = cwp[CONVD + cp], cw2 = cwp[2 * CONVD + cp], cw3 = cwp[3 * CONVD + cp], cbias = cbp_[cp];
        { const bf16* xb_ = xs + tok0 * SI; const bool hp_ = (c > 0) || (w > 0); int ox_ = oX;
#pragma unroll
          for (int i_ = 0; i_ < 35; ++i_) { rawx[i_] = (i_ >= 3 || hp_) ? xb_[ox_] : (unsigned short)0; ox_ += SI; asm volatile("" : "+v"(ox_)); } }
        { const bf16* cbb = CBm + tbase;
#pragma unroll
          for (int ks = 0; ks < 8; ++ks) cbf[ks] = (ks < 2 * w + 2) ? *(const u32x4*)(cbb + ((w * 8 + ks) * 64 + lane) * 8) : (u32x4){0u, 0u, 0u, 0u};
          if (c > 0) { const bf16* ccb = Ccg + tbase;
#pragma unroll
              for (int q = 0; q < 8; ++q) { const u32x4 t_ = *(const u32x4*)(ccb + ((w * 8 + q) * 64 + lane) * 8); ccf[2 * q].x = t_.x; ccf[2 * q].y = t_.y; ccf[2 * q + 1].x = t_.z; ccf[2 * q + 1].y = t_.w; } }
        }
        if (w == 0) {
            const float d0 = softplus_fast(dr0 + dtb), d1 = softplus_fast(dr1 + dtb);
            const float a0 = d0 * A2, a1 = d1 * A2; float s = a0 + a1;
#pragma unroll
            for (int o = 1; o < 64; o <<= 1) { const float t = __shfl_up(s, o); if (lane >= o) s += t; }
            const float aend_ = __shfl(s, 63);
            SC[2 * lane] = s - a1; SC[2 * lane + 1] = s; SC[128 + 2 * lane] = (s - a1) - __builtin_amdgcn_logf(d0); SC[129 + 2 * lane] = s - __builtin_amdgcn_logf(d1);
            SC[256 + 2 * lane] = d0 * __builtin_amdgcn_exp2f(aend_ - (s - a1)); SC[257 + 2 * lane] = d1 * __builtin_amdgcn_exp2f(aend_ - s);
        }
        {
            float h0 = bf2f(rawx[0]), h1 = bf2f(rawx[1]), h2 = bf2f(rawx[2]);
#pragma unroll
            for (int l8 = 0; l8 < 32; l8 += 8) {
                float v[8];
#pragma unroll
                for (int i = 0; i < 8; ++i) { const float cur = bf2f(rawx[3 + l8 + i]); v[i] = silu_fast(cbias + cw0 * h0 + cw1 * h1 + cw2 * h2 + cw3 * cur); h0 = h1; h1 = h2; h2 = cur; }
                u32x4 o0; o0.x = pk(v[0], v[1]); o0.y = pk(v[2], v[3]); o0.z = pk(v[4], v[5]); o0.w = pk(v[6], v[7]);
                *(LAS u32x4*)(L + U_XS + cp * ROWB + (32 * w + l8) * 2) = o0;
            }
        }
        if (c + 1 < NCH) SSD_PREF(c + 1);
        __syncthreads();
        f32x16 Y[2]; Y[0] = f32x16{}; Y[1] = f32x16{};
        if (c > 0) {
            lptr HFr = L + U_HF + ((c - 1) & 1) * 16384;
#pragma unroll
            for (int wb = 0; wb < 4; ++wb)
#pragma unroll
                for (int s = 0; s < 2; ++s) {
                    u32x4 au; au.x = ccf[2 * (2 * wb + s)].x; au.y = ccf[2 * (2 * wb + s)].y; au.z = ccf[2 * (2 * wb + s) + 1].x; au.w = ccf[2 * (2 * wb + s) + 1].y; const bf16x8 cfr = __builtin_bit_cast(bf16x8, au);
#pragma unroll
                    for (int pb = 0; pb < 2; ++pb) { const bf16x8 hb = *(const LAS bf16x8*)(HFr + (((wb * 2 + pb) * 2 + s) * 64 + lane) * 16); Y[pb] = __builtin_amdgcn_mfma_f32_32x32x16_bf16(hb, cfr, Y[pb], 0, 0, 0); }
                    __builtin_amdgcn_sched_barrier(0);
                }
            const float e = __builtin_amdgcn_exp2f(SC[32 * w + r32]);
#pragma unroll
            for (int r = 0; r < 16; ++r) { Y[0][r] *= e; Y[1][r] *= e; }
        }
        { const bf16* zb = cat + tok0 * CATP + 1024;
#pragma unroll
          for (int i = 0; i < 4; ++i) zq[i] = *(const u32x4*)(zb + (oR + 8 * i * CATP)); }
        u32x4 btf[8];
        { const bf16* bb = BcT + tbase;
#pragma unroll
          for (int ks = 0; ks < 8; ++ks) btf[ks] = *(const u32x4*)(bb + ((w * 8 + ks) * 64 + lane) * 8); }
        {
            const float al = SC[32 * w + r32];
#pragma unroll
            for (int ks = 0; ks < 8; ++ks) if (ks < 2 * w + 2) {
                const u32x4 cu = cbf[ks];
                const f32x4 q0 = *(const LAS f32x4*)(SC + 128 + 16 * ks + 8 * hi), q1 = *(const LAS f32x4*)(SC + 128 + 16 * ks + 8 * hi + 4);
                float m[8];
                m[0] = bflo(cu.x) * __builtin_amdgcn_exp2f(al - q0[0]); m[1] = bfhi(cu.x) * __builtin_amdgcn_exp2f(al - q0[1]); m[2] = bflo(cu.y) * __builtin_amdgcn_exp2f(al - q0[2]); m[3] = bfhi(cu.y) * __builtin_amdgcn_exp2f(al - q0[3]);
                m[4] = bflo(cu.z) * __builtin_amdgcn_exp2f(al - q1[0]); m[5] = bfhi(cu.z) * __builtin_amdgcn_exp2f(al - q1[1]); m[6] = bflo(cu.w) * __builtin_amdgcn_exp2f(al - q1[2]); m[7] = bfhi(cu.w) * __builtin_amdgcn_exp2f(al - q1[3]);
                if (ks >= 2 * w) {
                    int dd = r32 - (16 * ks + 8 * hi - 32 * w); asm volatile("" : "+v"(dd));
#pragma unroll
                    for (int j = 0; j < 8; ++j) { if (j > dd) m[j] = 0.f; if (j == dd) m[j] += dsk; }
                }
                u32x4 mu; mu.x = pk(m[0], m[1]); mu.y = pk(m[2], m[3]); mu.z = pk(m[4], m[5]); mu.w = pk(m[6], m[7]); const bf16x8 mf = __builtin_bit_cast(bf16x8, mu);
#pragma unroll
                for (int pb = 0; pb < 2; ++pb) { const bf16x8 xb = *(const LAS bf16x8*)(L + U_XS + (32 * pb + r32) * ROWB + (16 * ks + 8 * hi) * 2); Y[pb] = __builtin_amdgcn_mfma_f32_32x32x16_bf16(xb, mf, Y[pb], 0, 0, 0); }
                __builtin_amdgcn_sched_barrier(0);
            }
        }
        {
            lptr ST = L + U_ST + 32 * w * STP;
#pragma unroll
            for (int i = 0; i < 4; ++i) { lptr p_ = ST + (8 * i + (lane >> 3)) * STP + 16 * (lane & 7); u32x2 a_, b_; a_.x = zq[i].x; a_.y = zq[i].y; b_.x = zq[i].z; b_.y = zq[i].w; *(LAS u32x2*)p_ = a_; *(LAS u32x2*)(p_ + 8) = b_; }
            asm volatile("s_waitcnt lgkmcnt(0)" ::: "memory");
            float sq = 0.f; lptr rowp = ST + r32 * STP + 8 * hi;
#pragma unroll
            for (int pb = 0; pb < 2; ++pb)
#pragma unroll
                for (int gq = 0; gq < 4; ++gq) { const u32x2 zz = *(const LAS u32x2*)(rowp + 64 * pb + 16 * gq); u32x2 o;
                    const float y0 = Y[pb][4 * gq] * silu_fast(bflo(zz.x)), y1 = Y[pb][4 * gq + 1] * silu_fast(bfhi(zz.x)), y2 = Y[pb][4 * gq + 2] * silu_fast(bflo(zz.y)), y3 = Y[pb][4 * gq + 3] * silu_fast(bfhi(zz.y));
                    sq += (y0 * y0 + y1 * y1) + (y2 * y2 + y3 * y3); o.x = pk(y0, y1); o.y = pk(y2, y3);
                    *(LAS u32x2*)(rowp + 64 * pb + 16 * gq) = o; }
            sq += __shfl_xor(sq, 32);
            if (hi == 0) (ssq + tok0 * 32)[(32 * w + r32) * 32 + h] = sq;
            asm volatile("s_waitcnt lgkmcnt(0)" ::: "memory");
            bf16* yb_ = yout + tok0 * CATP + 1024;
#pragma unroll
            for (int i = 0; i < 4; ++i) { const lptr p_ = ST + (8 * i + (lane >> 3)) * STP + 16 * (lane & 7); const u32x2 a_ = *(const LAS u32x2*)p_, b_ = *(const LAS u32x2*)(p_ + 8);
                u32x4 o; o.x = a_.x; o.y = a_.y; o.z = b_.x; o.w = b_.y; *(u32x4*)(yb_ + (oR + 8 * i * CATP)) = o; }
        }
        {
            const float dec = __builtin_amdgcn_exp2f(SC[127]);
#pragma unroll
            for (int r = 0; r < 16; ++r) { Hs[0][r] *= dec; Hs[1][r] *= dec; }
#pragma unroll
            for (int ks = 0; ks < 8; ++ks) {
                const f32x4 f0 = *(const LAS f32x4*)(SC + 256 + 16 * ks + 8 * hi), f1 = *(const LAS f32x4*)(SC + 256 + 16 * ks + 8 * hi + 4);
                const u32x4 bu = btf[ks]; u32x4 au;
                au.x = pk(bflo(bu.x) * f0[0], bfhi(bu.x) * f0[1]); au.y = pk(bflo(bu.y) * f0[2], bfhi(bu.y) * f0[3]); au.z = pk(bflo(bu.z) * f1[0], bfhi(bu.z) * f1[1]); au.w = pk(bflo(bu.w) * f1[2], bfhi(bu.w) * f1[3]);
                const bf16x8 a = __builtin_bit_cast(bf16x8, au);
#pragma unroll
                for (int pb = 0; pb < 2; ++pb) { const bf16x8 xb = *(const LAS bf16x8*)(L + U_XS + (32 * pb + r32) * ROWB + (16 * ks + 8 * hi) * 2); Hs[pb] = __builtin_amdgcn_mfma_f32_32x32x16_bf16(a, xb, Hs[pb], 0, 0, 0); }
                __builtin_amdgcn_sched_barrier(0);
            }
            if (c + 1 < NCH) {
                lptr HFw = L + U_HF + (c & 1) * 16384;
#pragma unroll
                for (int pb = 0; pb < 2; ++pb)
#pragma unroll
                    for (int s = 0; s < 2; ++s) { u32x4 f; f.x = pk(Hs[pb][8 * s], Hs[pb][8 * s + 1]); f.y = pk(Hs[pb][8 * s + 2], Hs[pb][8 * s + 3]); f.z = pk(Hs[pb][8 * s + 4], Hs[pb][8 * s + 5]); f.w = pk(Hs[pb][8 * s + 6], Hs[pb][8 * s + 7]);
                        *(LAS u32x4*)(HFw + (((w * 2 + pb) * 2 + s) * 64 + lane) * 16) = f; }
            }
        }
        __syncthreads();
    }
#undef SSD_PREF
    if (un == 0) __syncthreads();
    __syncthreads();
}
}

constexpr int CW_BAR = 4096;
#define RLX_AGENT __ATOMIC_RELAXED, __HIP_MEMORY_SCOPE_AGENT
#define LDS_WAIT() asm volatile("s_waitcnt lgkmcnt(0)" ::: "memory")
#define VM_WAIT() asm volatile("s_waitcnt vmcnt(0)" ::: "memory")
#define XB_TMO      128
#define XB_XCNT(j)  (256  + 64 * (j))
#define XB_XSUB(j)  (1280 + 64 * (j))
#define XB_XGEN(j)  (2304 + 64 * (j))
#define XB_TOP      3328
#define XB_TOPGEN   3392
#define XCD_BAR_WORDS 3456
#define XB_SPIN_CAP (1u << 27)
__device__ __forceinline__ unsigned xb_ld(unsigned* p)              { return __hip_atomic_load(p, __ATOMIC_RELAXED, __HIP_MEMORY_SCOPE_AGENT); }
__device__ __forceinline__ unsigned xb_add(unsigned* p, unsigned v) { return __hip_atomic_fetch_add(p, v, __ATOMIC_RELAXED, __HIP_MEMORY_SCOPE_AGENT); }
__device__ __forceinline__ unsigned xb_xcc_id() { return (unsigned)__builtin_amdgcn_s_getreg((3 << 11) | 20) & 0xFu; }
#define XB_SPIN(cond, bar) do { unsigned _sp = 0; while (cond) { __builtin_amdgcn_s_sleep(1); \
    if ((++_sp & 255u) == 0u) { if (xb_ld(&(bar)[XB_TMO])) break; if (_sp > XB_SPIN_CAP) { atomicAdd(&(bar)[XB_TMO], 1u); break; } } } } while (0)
struct XcdBarrier { unsigned* bar; unsigned x; volatile LAS unsigned* st; };
__device__ __forceinline__ XcdBarrier xcd_barrier_post(unsigned* bar, volatile LAS unsigned* st) {
    XcdBarrier b; b.bar = bar; b.x = xb_xcc_id(); b.st = st;
    if (tidx() == 0) (void)xb_add(&bar[XB_XCNT(b.x)], 1u);
    return b;
}
__device__ __forceinline__ void xcd_barrier_complete(unsigned* bar, unsigned x, unsigned& nloc, unsigned& nx) {
    const unsigned G = gridDim.x * gridDim.y * gridDim.z;
    unsigned sum, cnt, mine, sp = 0u;
    for (;;) {
        sum = 0u; cnt = 0u; mine = 0u;
#pragma unroll
        for (unsigned j = 0; j < 16; ++j) { const unsigned c = xb_ld(&bar[XB_XCNT(j)]); sum += c; cnt += (c > 0u) ? 1u : 0u; mine = (j == x) ? c : mine; }
        if (sum == G) break;
        __builtin_amdgcn_s_sleep(1);
        if ((++sp & 255u) == 0u) { if (xb_ld(&bar[XB_TMO])) break; if (sp > XB_SPIN_CAP) { atomicAdd(&bar[XB_TMO], 1u); break; } }
    }
    nloc = mine > 0u ? mine : 1u; nx = cnt > 0u ? cnt : 1u;
}
__device__ __forceinline__ void xcd_barrier(const XcdBarrier& b) {
    asm volatile("s_waitcnt vmcnt(0)" ::: "memory");
    __syncthreads();
    if (tidx() == 0) {
        unsigned* bar = b.bar;
        __builtin_amdgcn_s_waitcnt(0);
        unsigned nloc = b.st[0], nx = b.st[1];
        if (nloc == 0u) { xcd_barrier_complete(bar, b.x, nloc, nx); b.st[0] = nloc; b.st[1] = nx; }
        const unsigned old = xb_add(&bar[XB_XSUB(b.x)], 1u);
        const unsigned gen = old / nloc;
        if (old + 1u == (gen + 1u) * nloc) {
            __builtin_amdgcn_fence(__ATOMIC_RELEASE, "agent");
            asm volatile("s_waitcnt vmcnt(0)" ::: "memory");
            const unsigned og = xb_add(&bar[XB_TOP], 1u);
            const unsigned tg = og / nx;
            if (og + 1u == (tg + 1u) * nx) xb_add(&bar[XB_TOPGEN], 1u);
            else XB_SPIN(xb_ld(&bar[XB_TOPGEN]) == tg, bar);
            __builtin_amdgcn_fence(__ATOMIC_ACQUIRE, "agent");
            xb_add(&bar[XB_XGEN(b.x)], 1u);
            asm volatile("s_waitcnt vmcnt(0)" ::: "memory");
        } else {
            XB_SPIN(xb_ld(&bar[XB_XGEN(b.x)]) == gen, bar);
            __builtin_amdgcn_fence(__ATOMIC_ACQUIRE, "agent");
            asm volatile("s_waitcnt vmcnt(0)" ::: "memory");
        }
    }
    __syncthreads();
}

__device__ __forceinline__ void p0_transpose_item(const float* W, int K, int Nsrc, int lcol0, bf16* WT, int n0, int k0, const float* kscale, LAS float* scr, int lane) {
    {
        const int c4 = lane & 7; f32x4 v[8];
#pragma unroll
        for (int i = 0; i < 8; ++i) { const int kk = 8 * i + (lane >> 3); v[i] = (f32x4){0.f, 0.f, 0.f, 0.f}; if (lcol0 >= 0) { v[i] = *(const f32x4*)(W + (size_t)(k0 + kk) * Nsrc + lcol0 + 4 * c4); if (kscale) v[i] = v[i] * kscale[k0 + kk]; } }
#pragma unroll
        for (int i = 0; i < 8; ++i) { const int kk = 8 * i + (lane >> 3); LAS float* d = scr + kk * 33 + 4 * c4; d[0] = v[i][0]; d[1] = v[i][1]; d[2] = v[i][2]; d[3] = v[i][3]; }
    }
    LDS_WAIT(); asm volatile("" ::: "memory");
    const int c = lane & 7;
#pragma unroll
    for (int j = 0; j < 4; ++j) { const int n = (lane >> 3) + 8 * j; const LAS float* s = scr + (8 * c) * 33 + n;
        u32x4 o; o.x = pg8::cvt_pk_bf16(s[0 * 33], s[1 * 33]); o.y = pg8::cvt_pk_bf16(s[2 * 33], s[3 * 33]); o.z = pg8::cvt_pk_bf16(s[4 * 33], s[5 * 33]); o.w = pg8::cvt_pk_bf16(s[6 * 33], s[7 * 33]);
        *(u32x4*)(WT + (size_t)(n0 + n) * K + k0 + 8 * c) = o; }
    LDS_WAIT(); asm volatile("" ::: "memory");
}


__device__ __forceinline__ void router_block(int rb, LAS unsigned char* lds, const float* __restrict__ x1, const float* __restrict__ g2, const float* __restrict__ modp, const float* __restrict__ rw, const float* __restrict__ rbias,
                                             bf16* __restrict__ u2p, unsigned* __restrict__ ctlp, int* __restrict__ listp, float* __restrict__ topkwp) {
    typedef float f32x16 __attribute__((ext_vector_type(16)));
    const int tid = tidx(), lane = tid & 63, wv = __builtin_amdgcn_readfirstlane(tid >> 6), r32 = lane & 31, hi = lane >> 5;
    const int row0 = rb * 128, b = row0 >> 11;
    const float* shift = modp + b * 6144 + 3 * D, *scale = modp + b * 6144 + 4 * D;
    LAS float* CV = (LAS float*)(lds + 135168);
    LAS unsigned* LCNT = (LAS unsigned*)(CV + 448);
    if (tid < 64) LCNT[tid] = 0u;
    constexpr int XP = 132;
    LAS float* XT = (LAS float*)(lds + wv * 16896);
    bf16x8 bh[8], bl[8]; float cpart = 0.f;
#pragma unroll
    for (int ks = 0; ks < 8; ++ks) { unsigned ph[4], pl[4];
#pragma unroll
        for (int j2 = 0; j2 < 4; ++j2) { float wv2[2], hv[2];
#pragma unroll
            for (int q = 0; q < 2; ++q) { const int k = 128 * wv + 16 * ks + 8 * hi + 2 * j2 + q; const float rwv = rw[(size_t)k * NE + r32]; cpart += shift[k] * rwv; wv2[q] = g2[k] * (1.f + scale[k]) * rwv; }
            ph[j2] = pg8::cvt_pk_bf16(wv2[0], wv2[1]); hv[0] = __uint_as_float(ph[j2] << 16); hv[1] = __uint_as_float(ph[j2] & 0xffff0000u); pl[j2] = pg8::cvt_pk_bf16(wv2[0] - hv[0], wv2[1] - hv[1]); }
        u32x4 uh, ul; uh.x = ph[0]; uh.y = ph[1]; uh.z = ph[2]; uh.w = ph[3]; ul.x = pl[0]; ul.y = pl[1]; ul.z = pl[2]; ul.w = pl[3]; bh[ks] = __builtin_bit_cast(bf16x8, uh); bl[ks] = __builtin_bit_cast(bf16x8, ul); }
    cpart += __shfl_xor(cpart, 32);
    if (hi == 0) CV[wv * NE + r32] = cpart;
    f32x16 acc[4]; float ssq[4];
#pragma unroll
    for (int rt = 0; rt < 4; ++rt) {
        acc[rt] = f32x16{};
        const float* src = x1 + (size_t)(row0 + 32 * rt) * D + 128 * wv;
#pragma unroll 1
        for (int i4 = 0; i4 < 16; i4 += 4) { f32x4 v[4];
#pragma unroll
            for (int i = 0; i < 4; ++i) { const int id = (i4 + i) * 64 + lane; v[i] = *(const f32x4*)(src + (size_t)(id >> 5) * D + 4 * (id & 31)); }
#pragma unroll
            for (int i = 0; i < 4; ++i) { const int id = (i4 + i) * 64 + lane; *(LAS f32x4*)(XT + (id >> 5) * XP + 4 * (id & 31)) = v[i]; } }
        asm volatile("s_waitcnt lgkmcnt(0)" ::: "memory");
        float s = 0.f;
#pragma unroll
        for (int ks = 0; ks < 8; ++ks) {
            const f32x4 a0 = *(const LAS f32x4*)(XT + r32 * XP + 16 * ks + 8 * hi), a1 = *(const LAS f32x4*)(XT + r32 * XP + 16 * ks + 8 * hi + 4);
            s += (a0[0] * a0[0] + a0[1] * a0[1]) + (a0[2] * a0[2] + a0[3] * a0[3]) + (a1[0] * a1[0] + a1[1] * a1[1]) + (a1[2] * a1[2] + a1[3] * a1[3]);
            u32x4 uh, ul; float h0, h1;
            uh.x = pg8::cvt_pk_bf16(a0[0], a0[1]); h0 = __uint_as_float(uh.x << 16); h1 = __uint_as_float(uh.x & 0xffff0000u); ul.x = pg8::cvt_pk_bf16(a0[0] - h0, a0[1] - h1);
            uh.y = pg8::cvt_pk_bf16(a0[2], a0[3]); h0 = __uint_as_float(uh.y << 16); h1 = __uint_as_float(uh.y & 0xffff0000u); ul.y = pg8::cvt_pk_bf16(a0[2] - h0, a0[3] - h1);
            uh.z = pg8::cvt_pk_bf16(a1[0], a1[1]); h0 = __uint_as_float(uh.z << 16); h1 = __uint_as_float(uh.z & 0xffff0000u); ul.z = pg8::cvt_pk_bf16(a1[0] - h0, a1[1] - h1);
            uh.w = pg8::cvt_pk_bf16(a1[2], a1[3]); h0 = __uint_as_float(uh.w << 16); h1 = __uint_as_float(uh.w & 0xffff0000u); ul.w = pg8::cvt_pk_bf16(a1[2] - h0, a1[3] - h1);
            const bf16x8 ah = __builtin_bit_cast(bf16x8, uh), al = __builtin_bit_cast(bf16x8, ul);
            acc[rt] = __builtin_amdgcn_mfma_f32_32x32x16_bf16(ah, bh[ks], acc[rt], 0, 0, 0);
            acc[rt] = __builtin_amdgcn_mfma_f32_32x32x16_bf16(al, bh[ks], acc[rt], 0, 0, 0);
            acc[rt] = __builtin_amdgcn_mfma_f32_32x32x16_bf16(ah, bl[ks], acc[rt], 0, 0, 0);
        }
        ssq[rt] = s + __shfl_xor(s, 32);
        asm volatile("s_waitcnt lgkmcnt(0)" ::: "memory");
    }
    __syncthreads();
    {
        LAS float* P = (LAS float*)lds + (size_t)wv * 128 * 33;
#pragma unroll
        for (int rt = 0; rt < 4; ++rt) {
#pragma unroll
            for (int r = 0; r < 16; ++r) P[(32 * rt + (r & 3) + 8 * (r >> 2) + 4 * hi) * 33 + r32] = acc[rt][r];
            if (hi == 0) P[(32 * rt + r32) * 33 + 32] = ssq[rt]; }
    }
    __syncthreads();
    if (tid < NE) { float s = rbias[tid];
#pragma unroll
        for (int q = 0; q < 8; ++q) s += CV[q * NE + tid];
        CV[256 + tid] = s; }
    __syncthreads();
    if (tid < 128) {
        const LAS float* P = (const LAS float*)lds + tid * 33;
        float lg[NE]; float sq = 0.f;
#pragma unroll
        for (int e = 0; e < NE; ++e) lg[e] = 0.f;
#pragma unroll
        for (int q = 0; q < 8; ++q) {
#pragma unroll
            for (int e = 0; e < NE; ++e) lg[e] += P[q * 128 * 33 + e];
            sq += P[q * 128 * 33 + 32]; }
        const float rs = rsqrtf(sq * (1.f / D) + EPS);
        CV[320 + tid] = rs;
#pragma unroll
        for (int e = 0; e < NE; ++e) lg[e] = lg[e] * rs + CV[256 + e];
        unsigned taken = 0u; int te[4]; float tl[4];
#pragma unroll
        for (int k = 0; k < 4; ++k) { float best = -INFINITY; int bi = 0;
#pragma unroll
            for (int e = 0; e < NE; ++e) { const float cand = ((taken >> e) & 1u) ? -INFINITY : lg[e]; if (cand > best) { best = cand; bi = e; } }
            taken |= 1u << bi; te[k] = bi; tl[k] = best; }
        const float w1 = __expf(tl[1] - tl[0]), w2 = __expf(tl[2] - tl[0]), w3 = __expf(tl[3] - tl[0]), inv = 1.f / ((1.f + w1) + (w2 + w3));
        const float wk[4] = {inv, w1 * inv, w2 * inv, w3 * inv};
        const int row = row0 + tid;
        unsigned lr[4];
#pragma unroll
        for (int k = 0; k < 4; ++k) lr[k] = __hip_atomic_fetch_add(LCNT + te[k], 1u, __ATOMIC_RELAXED, __HIP_MEMORY_SCOPE_WORKGROUP);
        __syncthreads();
        if (tid < NE) LCNT[32 + tid] = atomicAdd(&ctlp[CW_COUNTS + tid], LCNT[tid]);
        __syncthreads();
#pragma unroll
        for (int k = 0; k < 4; ++k) { listp[te[k] * LISTCAP + LCNT[32 + te[k]] + lr[k]] = row * 4 + k; topkwp[row * 4 + k] = wk[k]; }
    } else { __syncthreads(); __syncthreads(); }
    __syncthreads();
    for (int r = wv; r < 128; r += NWAVES) {
        const float rs = CV[320 + r]; const size_t ro = (size_t)(row0 + r) * D;
#pragma unroll
        for (int j = 0; j < 4; ++j) { const int col = 4 * lane + 256 * j; const f32x4 v = *(const f32x4*)(x1 + ro + col), gg = *(const f32x4*)(g2 + col), sc = *(const f32x4*)(scale + col), sh = *(const f32x4*)(shift + col);
            const f32x4 o = v * rs * gg * (sc + 1.f) + sh; u32x2 w; w.x = pg8::cvt_pk_bf16(o[0], o[1]); w.y = pg8::cvt_pk_bf16(o[2], o[3]); *(u32x2*)(u2p + ro + col) = w; }
    }
    __syncthreads();
}

struct Args { const float* in[26]; float* out; unsigned char* ws; int ph_lo, ph_hi, li, pad; };
constexpr int WGM_INPROJ = 6, WGM_MRG = 4, WGM_MOE1 = 4, WGM_MOE2 = 4;
enum { PH_PRO = 0, PH_NORM1, PH_INPROJ, PH_MIX1, PH_MIX2, PH_GNORM, PH_MRGA, PH_MRGB, PH_OUT, PH_ROUTER, PH_MOE1, PH_MOE2, PH_FINAL, PH_COUNT };

__global__ void __launch_bounds__(NWAVES * 64, 2) mega(Args args_unused) {
    typedef const __attribute__((address_space(4))) Args* ArgP;
    ArgP ap = (ArgP)__builtin_amdgcn_kernarg_segment_ptr();
    asm volatile("" : "+s"(ap));
    extern __shared__ __attribute__((aligned(16))) unsigned char lds_raw[];
    LAS unsigned char* lds = (LAS unsigned char*)lds_raw;
    volatile LAS int* LCTL = (volatile LAS int*)(lds + LCTL_OFF);
    const int G = gridDim.x, bx = blockIdx.x, NGW = G * NWAVES;
#define PHASE_IDS() const int tid = tidx(), lane = tid & 63, wave = __builtin_amdgcn_readfirstlane(tid >> 6), gw = bx * NWAVES + wave; (void)tid; (void)lane; (void)wave; (void)gw
#define ws (ap->ws)
#define ctl ((unsigned*)(ws + OFF_CTL))
#define xin (ap->in[0])
#define out (ap->out)
#define mod ((float*)(ws + OFF_MOD))
#define relb ((float*)(ws + OFF_RELB))
#define kmean ((float*)(ws + OFF_KMEAN))
#define topkw ((float*)(ws + OFF_TOPKW))
#define list ((int*)(ws + OFF_LIST))
#define dtraw ((float*)(ws + OFF_DTRAW))
#define WinT ((bf16*)(ws + OFF_WIN))
#define WaT ((bf16*)(ws + OFF_WA))
#define WsT ((bf16*)(ws + OFF_WS))
#define WoT ((bf16*)(ws + OFF_WO))
#define W1T ((bf16*)(ws + OFF_W1))
#define W2T ((bf16*)(ws + OFF_W2))
#define ub ((bf16*)(ws + OFF_U))
#define cat ((bf16*)(ws + OFF_CAT))
#define kb ((bf16*)(ws + OFF_K))
#define vb ((bf16*)(ws + OFF_V))
#define xs ((bf16*)(ws + OFF_XS))
#define brw ((bf16*)(ws + OFF_BR))
#define crw ((bf16*)(ws + OFF_CR))
#define gates ((bf16*)(ws + OFF_GATES))
#define u2 ((bf16*)(ws + OFF_U2))
#define hb ((bf16*)(ws + OFF_HB))
#define yb ((bf16*)(ws + OFF_YB))
#define merged kb
    {
        const int t0 = (int)__builtin_amdgcn_workitem_id_x();
        for (int i = t0; i < (LDS_BYTES - LCTL_OFF) / 4; i += NWAVES * 64) ((LAS unsigned*)(lds + LCTL_OFF))[i] = 0u;
        __syncthreads();
        if ((t0 & 63) == 0) LCTL[192 + hw_wave_slot()] = t0 >> 6;
        __syncthreads();
    }
    const int lo = ap->ph_lo, hi = ap->ph_hi;
    XcdBarrier bar; bar.bar = ctl + CW_BAR + ap->li * XCD_BAR_WORDS; bar.x = 0; bar.st = nullptr;
    if (hi - lo > 1) bar = xcd_barrier_post(ctl + CW_BAR + ap->li * XCD_BAR_WORDS, (volatile LAS unsigned*)(LCTL + 128));
#define IN(k) (lo <= (k) && (k) < hi)
#define SEAM(k) do { if (IN(k) && IN((k) + 1)) xcd_barrier(bar); } while (0)

    if (IN(PH_PRO)) {
        PHASE_IDS();
        const float* c = ap->in[1]; const float* ada_w = ap->in[2]; const float* ada_b = ap->in[3];
        const int gt = bx * (NWAVES * 64) + tid;
        {
            const int b0 = (bx * (NWAVES * 64)) / 6144; LAS float* cs = (LAS float*)lds;
            for (int i = tid; i < 2 * D; i += NWAVES * 64) { const int bb = b0 + (i >> 10); cs[i] = bb < NBATCH ? siluf(c[bb * D + (i & 1023)]) : 0.f; }
            __syncthreads();
            if (gt < NBATCH * 6144) { const int j = gt % 6144, b = gt / 6144; const LAS float* cb = cs + (b - b0) * D; float a0 = 0.f, a1 = 0.f, a2 = 0.f, a3 = 0.f;
#pragma unroll 4
                for (int k = 0; k < D; k += 4) { a0 += cb[k] * ada_w[(size_t)k * 6144 + j]; a1 += cb[k + 1] * ada_w[(size_t)(k + 1) * 6144 + j]; a2 += cb[k + 2] * ada_w[(size_t)(k + 2) * 6144 + j]; a3 += cb[k + 3] * ada_w[(size_t)(k + 3) * 6144 + j]; }
                mod[gt] = ada_b[j] + ((a0 + a1) + (a2 + a3)); }
            __syncthreads();
        }
        if (gt < NH * SEQ) { const int d = gt & (SEQ - 1), h = gt >> 11; int bucket = d;
            if (d >= 16) bucket = 16 + (d >= 21) + (d >= 27) + (d >= 35) + (d >= 46) + (d >= 59) + (d >= 77) + (d >= 99) + (d >= 128) + (d >= 166) + (d >= 216) + (d >= 280) + (d >= 363) + (d >= 470) + (d >= 609) + (d >= 790);
            relb[gt] = ap->in[8][bucket * NH + h] * LOG2E; }
        if (gt < NBATCH * 8 * NH * HD) kmean[gt] = 0.f;
        LAS float* scr = (LAS float*)(lds + wave * 16384);
        constexpr int I_IN = 16 * (NPROJ_PAD / 32), I_A = 16 * 32, I_S = 32 * 32, I_O = 16 * 32, I_1 = 16 * 64, I_2 = 16 * 32;
        constexpr int NITEMS = I_IN + I_A + I_S + I_O + NE * I_1 + NE * I_2;
        for (int it = gw; it < NITEMS; it += NGW) {
            int r = it;
            if (r < I_IN) { const int nb = r % (NPROJ_PAD / 32), kb_ = r / (NPROJ_PAD / 32); p0_transpose_item(ap->in[5], D, NPROJ, win_logical(nb * 32), WinT, nb * 32, kb_ * 64, nullptr, scr, lane); continue; } r -= I_IN;
            if (r < I_A) { const int nb = r % 32, kb_ = r / 32; p0_transpose_item(ap->in[15], D, D, nb * 32, WaT, nb * 32, kb_ * 64, nullptr, scr, lane); continue; } r -= I_A;
            if (r < I_S) { const int nb = r % 32, kb_ = r / 32; p0_transpose_item(ap->in[16], SI, D, nb * 32, WsT, nb * 32, kb_ * 64, ap->in[14], scr, lane); continue; } r -= I_S;
            if (r < I_O) { const int nb = r % 32, kb_ = r / 32; p0_transpose_item(ap->in[18], D, D, nb * 32, WoT, nb * 32, kb_ * 64, nullptr, scr, lane); continue; } r -= I_O;
            if (r < NE * I_1) { const int e = r / I_1, q = r % I_1, nb = q % 64, kb_ = q / 64; p0_transpose_item(ap->in[22] + (size_t)e * D * 2048, D, 2048, w1_logical(nb * 32), W1T + (size_t)e * 2048 * D, nb * 32, kb_ * 64, nullptr, scr, lane); continue; } r -= NE * I_1;
            { const int e = r / I_2, q = r % I_2, nb = q % 32, kb_ = q / 32; p0_transpose_item(ap->in[24] + (size_t)e * FF * D, FF, D, nb * 32, W2T + (size_t)e * D * FF, nb * 32, kb_ * 64, nullptr, scr, lane); }
        }
    }
    SEAM(PH_PRO);
    if (IN(PH_NORM1)) {
        PHASE_IDS();
        const float* g1 = ap->in[4];
        for (int row = gw; row < T; row += NGW) {
            const int b = row >> 11; f32x4 v[4]; float s = 0.f;
#pragma unroll
            for (int j = 0; j < 4; ++j) { v[j] = *(const f32x4*)(xin + (size_t)row * D + 4 * lane + 256 * j); s += (v[j].x * v[j].x + v[j].y * v[j].y) + (v[j].z * v[j].z + v[j].w * v[j].w); }
            const float rs = rsqrtf(wave_sum(s) * (1.f / D) + EPS);
            const float* shift = mod + b * 6144, *scale = shift + D;
#pragma unroll
            for (int j = 0; j < 4; ++j) { const int col = 4 * lane + 256 * j; const f32x4 gg = *(const f32x4*)(g1 + col), sc = *(const f32x4*)(scale + col), sh = *(const f32x4*)(shift + col);
                const f32x4 o = v[j] * rs * gg * (sc + 1.f) + sh; u32x2 w; w.x = pg8::cvt_pk_bf16(o[0], o[1]); w.y = pg8::cvt_pk_bf16(o[2], o[3]); *(u32x2*)(ub + (size_t)row * D + col) = w; }
        }
    }
    SEAM(PH_NORM1);
    if (IN(PH_INPROJ)) {
        pg8::Gemm g{nullptr, D, D, D}; pg8::StaticOrder S; S.init(T, NPROJ_PAD, G, bx, ub, D, WinT, D, WGM_INPROJ);
        epi::EpiInProj E{ws, ap->in[6], ap->in[7], kmean};
        pg8::gemm_phase<epi::EpiInProj, pg8::StaticOrder, false>(lds, g, S, E, nullptr);
    }
    SEAM(PH_INPROJ);
    if (IN(PH_MIX1)) {
        bf16* Ccg = (bf16*)(ws + OFF_U); bf16* BcTg = (bf16*)(ws + OFF_U + 32 * MiB); bf16* CBm = (bf16*)(ws + OFF_CB);
        for (int un = bx; un < NBATCH * ssd::NCH * SG; un += G) ssd::pre_unit(un, lds, brw, crw, ap->in[9], ap->in[10], CBm, Ccg, BcTg);
        __syncthreads();
        const int vcu = (G % 8 == 0) ? (bx % 8) * (G / 8) + bx / 8 : bx;
        if (ap->pad != 2) for (int bh = vcu; bh < NBATCH * NH; bh += G) {
            const int b = bh >> 4, h = bh & 15;
            attn_body::fill_tables((char*)lds_raw, relb + h * SEQ); __syncthreads();
            bf16* Op = ap->pad ? (bf16*)(ws + OFF_YB) : cat; asm volatile("" : "+s"(Op));
            for (int qb = 7; qb >= 0; --qb) attn_body::attn_unit<8>(b, h, qb, cat, kb, vb, Op, kmean + ((size_t)b * 8 * NH + h) * 64, (char*)lds_raw);
            __syncthreads();
        }
    }
    SEAM(PH_MIX1);
    if (IN(PH_MIX2)) {
        PHASE_IDS();
        const bf16* Ccg = (const bf16*)(ws + OFF_U); const bf16* BcTg = (const bf16*)(ws + OFF_U + 32 * MiB); const bf16* CBm = (const bf16*)(ws + OFF_CB);
        for (int pr = bx; pr < NBATCH * SH / 2; pr += G)
            ssd::main_pair(2 * pr + (wave >> 2), lds, cat, ap->pad ? (bf16*)(ws + OFF_YB) : cat, ap->pad ? (float*)(ws + OFF_YB) : (float*)(ws + OFF_SSQ), xs, dtraw, CBm, Ccg, BcTg, ap->in[9], ap->in[10], ap->in[11], ap->in[12], ap->in[13]);
    }
    SEAM(PH_MIX2);
    if (IN(PH_MRGA)) {
        pg8::Gemm g{nullptr, CATP, D, D}; pg8::StaticOrder S; S.init(T, D, G, bx, cat, CATP, WaT, D, WGM_MRG);
        epi::EpiMergedA E{ws, ap->in[17]};
        pg8::gemm_phase<epi::EpiMergedA, pg8::StaticOrder, false>(lds, g, S, E, nullptr);
    }
    if (IN(PH_MRGB)) {
        pg8::Gemm g{nullptr, CATP, SI, SI}; pg8::StaticOrder S; S.init(T, D, G, bx, cat + 1024, CATP, WsT, SI, WGM_MRG);
        epi::EpiMergedB E{ws, ap->in[17]};
        pg8::gemm_phase<epi::EpiMergedB, pg8::StaticOrder, false>(lds, g, S, E, nullptr);
    }
    SEAM(PH_MRGB);
    if (IN(PH_OUT)) {
        pg8::Gemm g{nullptr, D, D, D}; pg8::StaticOrder S; S.init(T, D, G, bx, merged, D, WoT, D, WGM_MRG);
        epi::EpiOut E{xin, mod, out};
        pg8::gemm_phase<epi::EpiOut, pg8::StaticOrder, false>(lds, g, S, E, nullptr);
    }
    SEAM(PH_OUT);
    if (IN(PH_ROUTER)) {
        const bool dry = ap->pad == 1;
        for (int rb = bx; rb < T / 128; rb += G) router_block(rb, lds, out, ap->in[19], mod, ap->in[20], ap->in[21], u2, dry ? ctl + 64 : ctl, dry ? (int*)(ws + OFF_YB) : list, dry ? (float*)(ws + OFF_YB + 8 * MiB) : topkw);
    }
    SEAM(PH_ROUTER);
    if (IN(PH_MOE1) || IN(PH_MOE2)) {
        PHASE_IDS();
        if (tid == 0) { int a = 0; for (int e = 0; e < NE; ++e) { const int cnt = (int)__hip_atomic_load(ctl + CW_COUNTS + e, RLX_AGENT); LCTL[e] = a; LCTL[64 + e] = cnt; a += (cnt + 255) >> 8; } LCTL[NE] = a; }
        __syncthreads();
    }
    if (IN(PH_MOE1)) {
        PHASE_IDS();
        pg8::MoeOrder S; S.init(LCTL, 2048, G, bx, nullptr, D, W1T, D, (size_t)2048 * D * 2, WGM_MOE1);
        LAS unsigned* tab = (LAS unsigned*)(lds + TAB_OFF);
        { pg8::Unit u; for (int i = 0; S.next(i, u); ++i) if (tid < 256) { const int slot = (u.pm - LCTL[u.e]) * 256 + tid; const bool valid = slot < LCTL[64 + u.e];
              const int ent = list[u.e * LISTCAP + (valid ? slot : 0)]; tab[i * 256 + tid] = (unsigned)(ent >> 2) * (unsigned)(D * 2); } }
        __syncthreads();
        pg8::Gemm g{(const char*)u2, D, D, D};
        epi::EpiMoe1 E{ap->in[23], hb};
        pg8::gemm_phase<epi::EpiMoe1, pg8::MoeOrder, true>(lds, g, S, E, tab);
    }
    SEAM(PH_MOE1);
    if (IN(PH_MOE2)) {
        PHASE_IDS();
        pg8::MoeOrder S; S.init(LCTL, D, G, bx, hb, FF, W2T, FF, (size_t)D * FF * 2, WGM_MOE2);
        LAS int* tabE = (LAS int*)(lds + TAB_OFF); LAS float* tabW = (LAS float*)(lds + TAB_OFF + 12288);
        { pg8::Unit u; for (int i = 0; S.next(i, u); ++i) if (tid < 256) { const int slot = (u.pm - LCTL[u.e]) * 256 + tid; const bool valid = slot < LCTL[64 + u.e];
              const int ent = valid ? list[u.e * LISTCAP + slot] : -1; tabE[i * 256 + tid] = ent; tabW[i * 256 + tid] = valid ? topkw[ent] : 0.f; } }
        __syncthreads();
        pg8::Gemm g{nullptr, FF, FF, FF};
        epi::EpiMoe2 E{ap->in[25], yb, tabE, tabW};
        pg8::gemm_phase<epi::EpiMoe2, pg8::MoeOrder, false>(lds, g, S, E, nullptr);
    }
    SEAM(PH_MOE2);
    if (IN(PH_FINAL)) {
        PHASE_IDS();
        const int gt = bx * (NWAVES * 64) + tid, NT = G * NWAVES * 64;
        for (size_t i8 = gt; i8 < (size_t)T * D / 8; i8 += NT) {
            const size_t idx = i8 * 8; const int t = (int)(idx >> 10), n = (int)(idx & 1023), b = t >> 11;
            f32x4 s0 = {0.f, 0.f, 0.f, 0.f}, s1 = {0.f, 0.f, 0.f, 0.f};
#pragma unroll
            for (int k = 0; k < 4; ++k) { f32x4 a, c; epi::unpack8(*(const u32x4*)(yb + ((size_t)t * 4 + k) * D + n), a, c); s0 += a; s1 += c; }
            const float* g2 = mod + b * 6144 + 5 * D + n;
            float* dst = ap->pad == 1 ? (float*)(ws + OFF_HB) : out;
            *(f32x4*)(dst + idx) = *(const f32x4*)(out + idx) + *(const f32x4*)(g2) * s0; *(f32x4*)(dst + idx + 4) = *(const f32x4*)(out + idx + 4) + *(const f32x4*)(g2 + 4) * s1;
        }
    }
#undef IN
#undef SEAM
#undef PHASE_IDS
#undef ws
#undef ctl
#undef xin
#undef out
#undef mod
#undef relb
#undef kmean
#undef topkw
#undef list
#undef dtraw
#undef WinT
#undef WaT
#undef WsT
#undef WoT
#undef W1T
#undef W2T
#undef ub
#undef cat
#undef kb
#undef vb
#undef xs
#undef brw
#undef crw
#undef gates
#undef u2
#undef hb
#undef yb
#undef merged
}
static void launch_mega(const Args& base, int lo, int hi, int li, hipStream_t stream) {
    Args a = base; a.ph_lo = lo; a.ph_hi = hi; a.li = li;
    hipLaunchKernelGGL(mega, dim3(256), dim3(NWAVES * 64), LDS_BYTES, stream, a);
}
extern "C" void kernel_launch(void* const* d_in, const int* in_sizes, int n_in, void* d_out, int out_size, void* d_ws, size_t ws_size, hipStream_t stream) {
    if (n_in != 26 || ws_size < WS_NEED || out_size != T * D) { fprintf(stderr, "kernel_launch: unexpected sizes (n_in %d ws %zu out %d)\n", n_in, ws_size, out_size); return; }
    static bool attr_set = false;
    if (!attr_set) { (void)hipFuncSetAttribute((const void*)mega, hipFuncAttributeMaxDynamicSharedMemorySize, LDS_BYTES); attr_set = true; }
    const float* conv_w = (const float*)d_in[9]; const float* conv_b = (const float*)d_in[10]; const float* dt_bias = (const float*)d_in[11];
    const float* a_log = (const float*)d_in[12]; const float* d_skip = (const float*)d_in[13]; const float* norm2_g = (const float*)d_in[19];
    const float* router_w = (const float*)d_in[20]; const float* router_b = (const float*)d_in[21];
    char* ws = (char*)d_ws; float* out = (float*)d_out;
    unsigned* ctl = (unsigned*)(ws + OFF_CTL); float* mod = (float*)(ws + OFF_MOD); float* relb = (float*)(ws + OFF_RELB); float* kmean = (float*)(ws + OFF_KMEAN);
    float* topkw = (float*)(ws + OFF_TOPKW); int* list = (int*)(ws + OFF_LIST); float* dtraw = (float*)(ws + OFF_DTRAW);
    bf16* cat = (bf16*)(ws + OFF_CAT); bf16* kb = (bf16*)(ws + OFF_K); bf16* vb = (bf16*)(ws + OFF_V); bf16* xs = (bf16*)(ws + OFF_XS);
    bf16* brw = (bf16*)(ws + OFF_BR); bf16* crw = (bf16*)(ws + OFF_CR); bf16* u2 = (bf16*)(ws + OFF_U2);
    Args a{};
    for (int i = 0; i < 26; ++i) a.in[i] = (const float*)d_in[i];
    a.out = out; a.ws = (unsigned char*)d_ws;
    (void)hipMemsetAsync(ws + OFF_CTL, 0, 1 * MiB, stream);
    launch_mega(a, PH_PRO, PH_COUNT, 0, stream);
}
```

```cpp
#include <hip/hip_runtime.h>
#include <cstdint>
#include <cstdio>

typedef unsigned short bf16;
typedef short bf16x8 __attribute__((ext_vector_type(8)));
typedef float f32x4 __attribute__((ext_vector_type(4)));

constexpr int D = 1024, NBATCH = 16, SEQ = 2048, T = NBATCH * SEQ;
constexpr int NH = 16, HD = 64;
constexpr int SI = 2048, SH = 32, SP = 64, SG = 4, SN = 128, CONVD = 3072;
constexpr int NE = 32, FF = 1024;
constexpr int NPROJ = 10272, NPROJ_PAD = 10496;
constexpr int CATP = 3072;
constexpr int LISTCAP = 32768;
constexpr int MOE_ROWS = 4 * T + NE * 256;
constexpr float EPS = 1e-6f;
constexpr float LOG2E = 1.4426950408889634f;
constexpr float QSCALE = 0.125f * LOG2E;

constexpr size_t MiB = 1u << 20;
constexpr size_t OFF_CTL = 0;
constexpr size_t OFF_MOD = 1 * MiB;
constexpr size_t OFF_RELB = 1 * MiB + 512 * 1024;
constexpr size_t OFF_KMEAN = 2 * MiB;
constexpr size_t OFF_TOPKW = 3 * MiB + 512 * 1024;
constexpr size_t OFF_LIST = 4 * MiB;
constexpr size_t OFF_DTRAW = 8 * MiB;
constexpr size_t OFF_SSQ = 20 * MiB;
constexpr size_t OFF_RST = 16 * MiB;
constexpr size_t OFF_WIN = 24 * MiB;
constexpr size_t OFF_WA = 45 * MiB, OFF_WS = 47 * MiB, OFF_WO = 51 * MiB;
constexpr size_t OFF_W1 = 54 * MiB;
constexpr size_t OFF_W2 = 182 * MiB;
constexpr size_t OFF_U = 246 * MiB;
constexpr size_t OFF_CAT = 310 * MiB;
constexpr size_t OFF_K = 502 * MiB;
constexpr size_t OFF_V = 566 * MiB;
constexpr size_t OFF_XS = 630 * MiB;
constexpr size_t OFF_BR = 758 * MiB, OFF_CR = 790 * MiB;
constexpr size_t OFF_GATES = 822 * MiB;
constexpr size_t OFF_CB = 950 * MiB;
constexpr size_t OFF_U2 = 246 * MiB;
constexpr size_t OFF_HB = 310 * MiB;
constexpr size_t OFF_YB = 582 * MiB;
constexpr size_t WS_NEED = 982 * MiB;
constexpr int CW_COUNTS = 1024;
constexpr int CW_TILEBASE = 1088;

__device__ __forceinline__ float bf2f(bf16 v) { return __uint_as_float(((unsigned)v) << 16); }
__device__ __forceinline__ bf16 f2bf(float f) { unsigned u = __float_as_uint(f); return (bf16)((u + 0x7fffu + ((u >> 16) & 1u)) >> 16); }
__device__ __forceinline__ float siluf(float x) { return x / (1.f + __expf(-x)); }
__device__ __forceinline__ float sigm(float x) { return 1.f / (1.f + __expf(-x)); }
__device__ __forceinline__ float wave_sum(float v) {
#pragma unroll
    for (int o = 1; o < 64; o <<= 1) v += __shfl_xor(v, o);
    return v;
}
__device__ __forceinline__ float wave_max(float v) {
#pragma unroll
    for (int o = 1; o < 64; o <<= 1) v = fmaxf(v, __shfl_xor(v, o));
    return v;
}
__device__ __forceinline__ float softplusf(float x) { return x > 20.f ? x : log1pf(__expf(x)); }
__device__ __forceinline__ float silu_fast(float x) { return x * __builtin_amdgcn_rcpf(1.f + __builtin_amdgcn_exp2f(-LOG2E * x)); }
__device__ __forceinline__ float softplus_fast(float x) { const float t = __builtin_amdgcn_exp2f(LOG2E * x); return x > 20.f ? x : (t < 1e-3f ? t * (1.f - 0.5f * t) : 0.6931471805599453f * __builtin_amdgcn_logf(1.f + t)); }

__host__ __device__ __forceinline__ int win_logical(int n) {
    if (n >= NPROJ) return -1;
    const int tile = n >> 8;
    if (tile < 8) { const int l = n & 255, bj = (l >> 7) & 1, wc = (l >> 5) & 3, j = l & 31; return tile * 256 + 64 * wc + 32 * bj + j; }
    if (n < 8192) return n;
    if (n < 10240) return n + 32;
    return n - 2048;
}
__host__ __device__ __forceinline__ int w1_logical(int n) { const int pn = n >> 8, bj = (n >> 7) & 1, j = n & 127; return bj * 1024 + pn * 128 + j; }

constexpr int NWAVES = 8;
constexpr int RING_BYTES = 131072, TAB_OFF = RING_BYTES, TAB_BYTES = 24576, LCTL_OFF = TAB_OFF + TAB_BYTES, LDS_BYTES = 163840;
__device__ __forceinline__ int hw_wave_slot() { return (int)__builtin_amdgcn_s_getreg((5 << 11) | 4) & 63; }
__device__ __forceinline__ int lane_id() { return (int)__builtin_amdgcn_mbcnt_hi(~0u, __builtin_amdgcn_mbcnt_lo(~0u, 0u)); }
__device__ __forceinline__ int wave_idx() { extern __shared__ __attribute__((aligned(16))) unsigned char lds_raw_[]; return __builtin_amdgcn_readfirstlane(((volatile __attribute__((address_space(3))) int*)((__attribute__((address_space(3))) unsigned char*)lds_raw_ + LCTL_OFF))[192 + hw_wave_slot()]); }
__device__ __forceinline__ int tidx() { return wave_idx() * 64 + lane_id(); }

#define LAS __attribute__((address_space(3)))
#define GAS __attribute__((address_space(1)))
typedef unsigned u32x4 __attribute__((ext_vector_type(4)));
typedef unsigned u32x2 __attribute__((ext_vector_type(2)));
namespace pg8 {
constexpr int BM = 256, BK = 64, HALF = 128, HTB = HALF * BK * 2, STAGE_BYTES = 8 * HTB, NXCD = 8;
__host__ __device__ __forceinline__ int lds_byte(int r, int c) { const int st = (r >> 4) * 2 + (c >> 5), rr = r & 15, cc = c & 31, ob = rr * 64 + cc * 2; return st * 1024 + (ob ^ (((ob >> 9) & 1) << 5)); }
__host__ __device__ __forceinline__ void stage_rc(int b, int& R, int& C) { const int st = b / 1024, sb = b % 1024, swz = sb ^ (((sb >> 9) & 1) << 5); R = (st >> 1) * 16 + swz / 64; C = (st & 1) * 32 + (swz % 64) / 2; }
__host__ __device__ __forceinline__ int perm32(int rho) { const int n = rho >> 4, i = rho & 15; return 8 * (i >> 2) + 4 * n + (i & 3); }

struct Unit { int pm, pn, e; const char* a; const char* b; };
struct Gemm { const char* A; int lda, ldb, K; };

__device__ __forceinline__ void order_map(int L, int nM, int nN, int WGM, int& pm, int& pn) {
    const int nwg = nM * nN; int wgid = L;
    { const int q = nwg / NXCD, r = nwg % NXCD, xcd = wgid % NXCD, off = wgid / NXCD; wgid = (xcd < r ? xcd * (q + 1) : r * (q + 1) + (xcd - r) * q) + off; }
    const int nig = WGM * nN, gid = wgid / nig, fm = gid * WGM, gsz = (nM - fm) < WGM ? (nM - fm) : WGM;
    pm = fm + ((wgid % nig) % gsz); pn = (wgid % nig) / gsz;
}
struct StaticOrder {
    int nM, nN, nwg, G, c, wgm; const char* A; const char* B; size_t atile, btile;
    __device__ __forceinline__ void init(int M, int N, int G_, int c_, const void* A_, int lda, const void* B_, int ldb, int wgm_) { wgm = wgm_; nM = M / BM; nN = N / BM; nwg = nM * nN; G = G_; c = c_; A = (const char*)A_; B = (const char*)B_; atile = (size_t)BM * lda * 2; btile = (size_t)BM * ldb * 2; }
    __device__ __forceinline__ bool next(int i, Unit& u) const {
        const long L = (long)i * G + c; if (L >= nwg) return false;
        order_map((int)L, nM, nN, wgm, u.pm, u.pn); u.e = 0; u.a = A + (size_t)u.pm * atile; u.b = B + (size_t)u.pn * btile; return true;
    }
};
struct MoeOrder {
    int nM, nN, nwg, G, c, wgm; const volatile LAS int* tb; const char* A; const char* B; size_t atile, btile, estride;
    __device__ __forceinline__ void init(const volatile LAS int* tb_, int N, int G_, int c_, const void* A_, int lda, const void* B_, int ldb, size_t estride_, int wgm_) { wgm = wgm_;
        tb = tb_; nM = tb_[NE]; nN = N / BM; nwg = nM * nN; G = G_; c = c_; A = (const char*)A_; B = (const char*)B_; atile = (size_t)BM * lda * 2; btile = (size_t)BM * ldb * 2; estride = estride_; }
    __device__ __forceinline__ bool next(int i, Unit& u) const {
        const long L = (long)i * G + c; if (L >= nwg) return false;
        order_map((int)L, nM, nN, wgm, u.pm, u.pn);
        int e = 0;
        for (int k = 1; k < NE; ++k) e += (tb[k] <= u.pm) ? 1 : 0;
        u.e = __builtin_amdgcn_readfirstlane(e); u.a = A + (size_t)u.pm * atile; u.b = B + (size_t)u.e * estride + (size_t)u.pn * btile; return true;
    }
};

__device__ __forceinline__ unsigned cvt_pk_bf16(float lo, float hi) { unsigned r; asm volatile("v_cvt_pk_bf16_f32 %0, %1, %2" : "=v"(r) : "v"(lo), "v"(hi)); return r; }

template <class Epi, class Sched, bool GATHER>
__device__ __forceinline__ void gemm_phase(LAS unsigned char* lds, const Gemm g, const Sched& S, const Epi& E, const LAS unsigned* tab) {
    const int tid = tidx(), wid = __builtin_amdgcn_readfirstlane(tid >> 6), lane = tid & 63, wr = wid >> 2, wc = wid & 3, fr = lane & 15, fq = lane >> 4;
    const int K = g.K, nt = K / BK;
    unsigned voffA[2], voffB[2]; int R0, C0;
    { int R, C; stage_rc(tid * 16, R, C); R0 = R; C0 = C; }
#pragma unroll
    for (int i = 0; i < 2; ++i) { int R, C; stage_rc(tid * 16 + i * 8192, R, C); const int Rb = (R & ~31) + perm32(R & 31);
        voffA[i] = (unsigned)(R * g.lda + C) * 2u; voffB[i] = (unsigned)(Rb * g.ldb + C) * 2u; }
    const size_t kstep = (size_t)(BK * 2);
    const size_t hstepA = (size_t)HALF * g.lda * 2, hstepB = (size_t)HALF * g.ldb * 2;
    const unsigned ldsw = (unsigned)wid * 1024u;
    const int aoff = lds_byte(wr * 64 + fr, fq * 8), boff = lds_byte(wc * 32 + fr, fq * 8);
#define PG8_SA(b, h) (((b) * 2 + (h)) * HTB)
#define PG8_SB(b, h) ((4 + (b) * 2 + (h)) * HTB)
#define PG8_STAGE(bufoff, gbase, voff) do { _Pragma("unroll") for (int _i = 0; _i < 2; ++_i) \
        __builtin_amdgcn_global_load_lds((const unsigned*)((const char*)(gbase) + (voff)[_i]), (LAS unsigned*)(lds + (bufoff) + ldsw + _i * 8192), 16, 0, 0); } while (0)
#define PG8_STA(bufoff, kb, h, nx) do { if constexpr (GATHER) { unsigned _v[2]; _v[0] = (nx) ? gn[h][0] : gc[h][0]; _v[1] = (nx) ? gn[h][1] : gc[h][1]; PG8_STAGE(bufoff, g.A + (kb), _v); } \
        else { PG8_STAGE(bufoff, ((nx) ? nA : cA) + (kb) + (h) * hstepA, voffA); } } while (0)
#define PG8_LDA(dst, b, h) do { _Pragma("unroll") for (int m = 0; m < 4; ++m) _Pragma("unroll") for (int k = 0; k < 2; ++k) dst[m][k] = *(const LAS bf16x8*)(lds + PG8_SA(b, h) + aoff + m * 2048 + k * 1024); } while (0)
#define PG8_LDB(dst, b, h) do { _Pragma("unroll") for (int n = 0; n < 2; ++n) _Pragma("unroll") for (int k = 0; k < 2; ++k) dst[n][k] = *(const LAS bf16x8*)(lds + PG8_SB(b, h) + boff + n * 2048 + k * 1024); } while (0)
#define PG8_MMA(ai, bj, At, Bt) do { __builtin_amdgcn_s_setprio(1); _Pragma("unroll") for (int m = 0; m < 4; ++m) _Pragma("unroll") for (int n = 0; n < 2; ++n) _Pragma("unroll") for (int k = 0; k < 2; ++k) \
        acc[ai][bj][m][n] = __builtin_amdgcn_mfma_f32_16x16x32_bf16(Bt[n][k], At[m][k], acc[ai][bj][m][n], 0, 0, 0); __builtin_amdgcn_s_setprio(0); } while (0)
#define PG8_WAIT_V(n) asm volatile("s_waitcnt vmcnt(" #n ")" ::: "memory")
#define PG8_WAIT_L(n) asm volatile("s_waitcnt lgkmcnt(" #n ")" ::: "memory")
#define PG8_BAR __builtin_amdgcn_s_barrier()
#define PG8_SCHED __builtin_amdgcn_sched_barrier(0)
#define PG8_GOFF(dst, uidx) do { _Pragma("unroll") for (int h = 0; h < 2; ++h) _Pragma("unroll") for (int i = 0; i < 2; ++i) dst[h][i] = tab[(uidx) * 256 + h * 128 + i * 64 + R0] + (unsigned)(C0 * 2); } while (0)
    Unit cur, nxt; int ui = 0;
    if (!S.next(0, cur)) return;
    f32x4 acc[2][2][4][2];
#pragma unroll
    for (int a = 0; a < 2; ++a)
#pragma unroll
        for (int b = 0; b < 2; ++b)
#pragma unroll
            for (int m = 0; m < 4; ++m)
#pragma unroll
                for (int n = 0; n < 2; ++n) acc[a][b][m][n] = (f32x4){0.f, 0.f, 0.f, 0.f};
    bf16x8 At[4][2], B0[2][2], B1[2][2];
    const char* cA = cur.a; const char* cB = cur.b; const char* nA = cA;
    unsigned gc[2][2] = {{0u, 0u}, {0u, 0u}}, gn[2][2] = {{0u, 0u}, {0u, 0u}};
    if constexpr (GATHER) { PG8_GOFF(gc, 0); }
    PG8_STAGE(PG8_SB(0, 0), cB, voffB); PG8_STAGE(PG8_SB(0, 1), cB + hstepB, voffB); PG8_STA(PG8_SA(0, 0), 0, 0, false); PG8_STA(PG8_SA(0, 1), 0, 1, false);
    if (wr == 1) PG8_BAR;
    PG8_WAIT_V(2); PG8_BAR;
    PG8_STAGE(PG8_SB(1, 0), cB + kstep, voffB); PG8_STA(PG8_SA(1, 0), kstep, 0, false); PG8_STAGE(PG8_SB(1, 1), cB + hstepB + kstep, voffB);
    PG8_WAIT_V(6); PG8_BAR;
    for (;;) {
        const bool has_next = S.next(ui + 1, nxt);
        nA = has_next ? nxt.a : cA; const char* nB = has_next ? nxt.b : cB;
        if constexpr (GATHER) { if (has_next) { PG8_GOFF(gn, ui + 1); } else {
#pragma unroll
            for (int h = 0; h < 2; ++h) { gn[h][0] = gc[h][0]; gn[h][1] = gc[h][1]; } } }
        for (int t = 0; t < nt; t += 2) {
            if constexpr (Epi::HOOKS) { if (t == 8 || t == 16 || t == 24) E.hook(acc, cur, t, wr, fr); }
            const bool last = (t == nt - 2);
            const size_t k1 = (size_t)(t + 1) * kstep, k2 = last ? 0 : (size_t)(t + 2) * kstep, k3 = k2 + kstep;
            const char* b2 = last ? nB : cB + (size_t)(t + 2) * kstep; const char* b3 = b2 + kstep;
            PG8_LDB(B0, 0, 0); PG8_LDB(B1, 0, 1); PG8_SCHED; PG8_LDA(At, 0, 0); PG8_STA(PG8_SA(1, 1), k1, 1, false);
            PG8_WAIT_V(8); PG8_WAIT_L(0); PG8_BAR; PG8_MMA(0, 0, At, B0); PG8_MMA(0, 1, At, B1); PG8_BAR; PG8_SCHED;
            PG8_LDA(At, 0, 1); PG8_STAGE(PG8_SB(0, 0), b2, voffB); PG8_STAGE(PG8_SB(0, 1), b2 + hstepB, voffB); PG8_STA(PG8_SA(0, 0), k2, 0, last);
            PG8_WAIT_V(8); PG8_WAIT_L(0); PG8_BAR; PG8_MMA(1, 0, At, B0); PG8_MMA(1, 1, At, B1); PG8_BAR; PG8_SCHED;
            PG8_LDB(B0, 1, 0); PG8_LDB(B1, 1, 1); PG8_SCHED; PG8_LDA(At, 1, 0); PG8_STA(PG8_SA(0, 1), k2, 1, last);
            PG8_WAIT_V(8); PG8_WAIT_L(0); PG8_BAR; PG8_MMA(0, 0, At, B0); PG8_MMA(0, 1, At, B1); PG8_BAR; PG8_SCHED;
            PG8_LDA(At, 1, 1); PG8_STAGE(PG8_SB(1, 0), b3, voffB); PG8_STAGE(PG8_SB(1, 1), b3 + hstepB, voffB); PG8_STA(PG8_SA(1, 0), k3, 0, last);
            PG8_WAIT_V(8); PG8_WAIT_L(0); PG8_BAR; PG8_MMA(1, 0, At, B0); PG8_MMA(1, 1, At, B1); PG8_BAR; PG8_SCHED;
        }
        if (wr == 0) PG8_BAR;
        E(acc, cur, ui, wr, wc, fr, fq);
        if (!has_next) break;
#pragma unroll
        for (int a = 0; a < 2; ++a)
#pragma unroll
            for (int b = 0; b < 2; ++b)
#pragma unroll
                for (int m = 0; m < 4; ++m)
#pragma unroll
                    for (int n = 0; n < 2; ++n) acc[a][b][m][n] = (f32x4){0.f, 0.f, 0.f, 0.f};
        cur = nxt; cA = nA; cB = nB; ++ui;
        if constexpr (GATHER) {
#pragma unroll
            for (int h = 0; h < 2; ++h) { gc[h][0] = gn[h][0]; gc[h][1] = gn[h][1]; } }
        if (wr == 1) PG8_BAR;
    }
    PG8_WAIT_V(0);
    PG8_BAR;
#undef PG8_SA
#undef PG8_SB
#undef PG8_STAGE
#undef PG8_STA
#undef PG8_LDA
#undef PG8_LDB
#undef PG8_MMA
#undef PG8_WAIT_V
#undef PG8_WAIT_L
#undef PG8_BAR
#undef PG8_SCHED
#undef PG8_GOFF
}
}
namespace epi {
using pg8::Unit; using pg8::cvt_pk_bf16;
__device__ __forceinline__ u32x4 pack8(const f32x4& a, const f32x4& b) { u32x4 w; w.x = cvt_pk_bf16(a[0], a[1]); w.y = cvt_pk_bf16(a[2], a[3]); w.z = cvt_pk_bf16(b[0], b[1]); w.w = cvt_pk_bf16(b[2], b[3]); return w; }
__device__ __forceinline__ void unpack8(const u32x4& w, f32x4& a, f32x4& b) {
    a[0] = __uint_as_float(w.x << 16); a[1] = __uint_as_float(w.x & 0xffff0000u); a[2] = __uint_as_float(w.y << 16); a[3] = __uint_as_float(w.y & 0xffff0000u);
    b[0] = __uint_as_float(w.z << 16); b[1] = __uint_as_float(w.z & 0xffff0000u); b[2] = __uint_as_float(w.w << 16); b[3] = __uint_as_float(w.w & 0xffff0000u); }
typedef float f32x2_t __attribute__((ext_vector_type(2)));
__device__ __forceinline__ f32x4 sigm4(const f32x4& x) { f32x4 r; r[0] = sigm(x[0]); r[1] = sigm(x[1]); r[2] = sigm(x[2]); r[3] = sigm(x[3]); return r; }

struct EpiInProj { static constexpr bool HOOKS = false;
    unsigned char* wsb; const float *qg, *kg; float* kmean;
    __device__ __forceinline__ void operator()(const f32x4 (&acc)[2][2][4][2], const Unit& u, int ui, int wr, int wc, int fr, int fq) const {
        bf16* cat = (bf16*)(wsb + OFF_CAT); bf16* kb = (bf16*)(wsb + OFF_K); bf16* vb = (bf16*)(wsb + OFF_V); bf16* xs = (bf16*)(wsb + OFF_XS); bf16* brw = (bf16*)(wsb + OFF_BR); bf16* crw = (bf16*)(wsb + OFF_CR);
        bf16* gates = (bf16*)(wsb + OFF_GATES); float* dtraw = (float*)(wsb + OFF_DTRAW);
        const int pn = u.pn; const int row0 = u.pm * 256 + wr * 64 + fr;
        if (pn < 8) {
            const bool isq = pn < 4; const float* g = isq ? qg : kg; const float sc = isq ? QSCALE : 1.f;
            f32x4 gv[2][2], ks[2][2];
#pragma unroll
            for (int bj = 0; bj < 2; ++bj)
#pragma unroll
                for (int n = 0; n < 2; ++n) { gv[bj][n] = *(const f32x4*)(g + 32 * bj + 8 * fq + 4 * n) * sc; ks[bj][n] = (f32x4){0.f, 0.f, 0.f, 0.f}; }
            bf16* base = isq ? cat + (pn * 256 + 64 * wc + 8 * fq) : kb + ((pn - 4) * 256 + 64 * wc + 8 * fq); const size_t pitch = isq ? CATP : D;
#pragma unroll
            for (int ai = 0; ai < 2; ++ai)
#pragma unroll
                for (int m = 0; m < 4; ++m) {
                    float s = 0.f;
#pragma unroll
                    for (int bj = 0; bj < 2; ++bj)
#pragma unroll
                        for (int n = 0; n < 2; ++n) { const f32x4 x = acc[ai][bj][m][n]; s += (x[0] * x[0] + x[1] * x[1]) + (x[2] * x[2] + x[3] * x[3]); }
                    s += __shfl_xor(s, 16); s += __shfl_xor(s, 32);
                    const float rs = rsqrtf(s * (1.f / 64.f) + EPS);
                    bf16* rowp = isq ? base + (size_t)(row0 + ai * 128 + m * 16) * pitch
                                     : kb + ((size_t)((((u.pm >> 3) * 16 + (pn - 4) * 4 + wc) * 32 + ((u.pm * 4 + wr + 2 * ai) & 31)) * 4096 + fq * 512 + (fr + 16 * m) * 8));
                    const int bjs = isq ? 32 : 2048;
#pragma unroll
                    for (int bj = 0; bj < 2; ++bj) { const f32x4 o0 = acc[ai][bj][m][0] * rs * gv[bj][0], o1 = acc[ai][bj][m][1] * rs * gv[bj][1];
                        *(u32x4*)(rowp + bjs * bj) = pack8(o0, o1); ks[bj][0] += o0; ks[bj][1] += o1; }
                }
            if (!isq) {
                float* km = kmean + ((size_t)u.pm * NH + (pn - 4) * 4 + wc) * 64 + 8 * fq;
#pragma unroll
                for (int bj = 0; bj < 2; ++bj)
#pragma unroll
                    for (int n = 0; n < 2; ++n)
#pragma unroll
                        for (int e = 0; e < 4; ++e) { float v = ks[bj][n][e]; v += __shfl_xor(v, 1); v += __shfl_xor(v, 2); v += __shfl_xor(v, 4); v += __shfl_xor(v, 8);
                            if (fr == 0) atomicAdd(km + 32 * bj + 4 * n + e, v * (1.f / 256.f)); }
            }
        } else if (pn < 12) {
#pragma unroll
            for (int ai = 0; ai < 2; ++ai)
#pragma unroll
                for (int m = 0; m < 4; ++m)
#pragma unroll
                    for (int bj = 0; bj < 2; ++bj) {
                        bf16* p = vb + ((size_t)((((u.pm >> 3) * 16 + (pn - 8) * 4 + 2 * bj + (wc >> 1)) * 32 + ((u.pm * 4 + wr + 2 * ai) & 31)) * 4096 + ((wc & 1) * 4 + m) * 512 + fr * 32 + 8 * fq));
                        __builtin_nontemporal_store(pack8(acc[ai][bj][m][0], acc[ai][bj][m][1]), (u32x4*)p); }
        } else if (pn < 40) {
            bf16* base; size_t pitch;
            if (pn < 20) { base = cat + 1024 + (pn - 12) * 256; pitch = CATP; }
            else if (pn < 28) { base = xs + (pn - 20) * 256; pitch = SI; }
            else if (pn < 30) { base = brw + (pn - 28) * 256; pitch = 512; }
            else if (pn < 32) { base = crw + (pn - 30) * 256; pitch = 512; }
            else { base = gates + (pn - 32) * 256; pitch = 2048; }
            base += wc * 32 + 8 * fq;
#pragma unroll
            for (int ai = 0; ai < 2; ++ai)
#pragma unroll
                for (int m = 0; m < 4; ++m) { bf16* rowp = base + (size_t)(row0 + ai * 128 + m * 16) * pitch;
#pragma unroll
                    for (int bj = 0; bj < 2; ++bj) __builtin_nontemporal_store(pack8(acc[ai][bj][m][0], acc[ai][bj][m][1]), (u32x4*)(rowp + bj * 128)); }
        } else if (wc == 0) {
#pragma unroll
            for (int ai = 0; ai < 2; ++ai)
#pragma unroll
                for (int m = 0; m < 4; ++m) { float* p = dtraw + (size_t)(row0 + ai * 128 + m * 16) * 32 + 8 * fq; *(f32x4*)p = acc[ai][0][m][0]; *(f32x4*)(p + 4) = acc[ai][0][m][1]; }
        }
    }
};
struct EpiMergedA { static constexpr bool HOOKS = false;
    unsigned char* wsb; const float* gb;
    __device__ __forceinline__ void operator()(const f32x4 (&acc)[2][2][4][2], const Unit& u, int ui, int wr, int wc, int fr, int fq) const {
        const bf16* gates = (const bf16*)(wsb + OFF_GATES); bf16* out = (bf16*)(wsb + OFF_K); const float* ssq = (const float*)(wsb + OFF_SSQ); float* rst = (float*)(wsb + OFF_RST);
        const int row0 = u.pm * 256 + wr * 64 + fr, col0 = u.pn * 256 + wc * 32 + 8 * fq;
        f32x2_t rso; { const int tid = tidx(); const size_t r = (size_t)u.pm * 256 + (tid & 255); const int g2 = (tid >> 8) * 2; const float* sp = ssq + r * 32 + 8 * g2;
          const f32x4 a = *(const f32x4*)(sp), b = *(const f32x4*)(sp + 4), c = *(const f32x4*)(sp + 8), d = *(const f32x4*)(sp + 12);
          rso.x = rsqrtf(((a[0] + a[1]) + (a[2] + a[3]) + (b[0] + b[1]) + (b[2] + b[3])) * (1.f / 512.f) + EPS); rso.y = rsqrtf(((c[0] + c[1]) + (c[2] + c[3]) + (d[0] + d[1]) + (d[2] + d[3])) * (1.f / 512.f) + EPS); }
        f32x4 bv[2][2];
#pragma unroll
        for (int bj = 0; bj < 2; ++bj) { bv[bj][0] = *(const f32x4*)(gb + col0 + bj * 128); bv[bj][1] = *(const f32x4*)(gb + col0 + bj * 128 + 4); }
#pragma unroll
        for (int ai = 0; ai < 2; ++ai) {
            u32x4 gq[4][2];
#pragma unroll
            for (int m = 0; m < 4; ++m)
#pragma unroll
                for (int bj = 0; bj < 2; ++bj) gq[m][bj] = *(const u32x4*)(gates + (size_t)(row0 + ai * 128 + m * 16) * 2048 + col0 + bj * 128);
#pragma unroll
            for (int m = 0; m < 4; ++m)
#pragma unroll
                for (int bj = 0; bj < 2; ++bj) { f32x4 g0, g1; unpack8(gq[m][bj], g0, g1);
                    *(u32x4*)(out + (size_t)(row0 + ai * 128 + m * 16) * D + col0 + bj * 128) = pack8(sigm4(g0 + bv[bj][0]) * acc[ai][bj][m][0], sigm4(g1 + bv[bj][1]) * acc[ai][bj][m][1]); }
        }
        { const int tid = tidx(); const size_t r = (size_t)u.pm * 256 + (tid & 255); const int g2 = (tid >> 8) * 2; *(f32x2_t*)(rst + ((size_t)u.pn * T + r) * 4 + g2) = rso; }
    }
};
struct EpiMergedB {
    static constexpr bool HOOKS = true;
    unsigned char* wsb; const float* gb;
    __device__ __forceinline__ void hook(f32x4 (&acc)[2][2][4][2], const Unit& u, int t, int wr, int fr) const {
        const float* rst = (const float*)(wsb + OFF_RST);
        const int g = (t >> 3) - 1;
#pragma unroll
        for (int ai = 0; ai < 2; ++ai)
#pragma unroll
            for (int m = 0; m < 4; ++m) { const size_t r = (size_t)(u.pm * 256 + wr * 64 + fr + ai * 128 + m * 16); const f32x4 rs = *(const f32x4*)(rst + ((size_t)u.pn * T + r) * 4);
                const float f = g == 0 ? rs[0] / rs[1] : (g == 1 ? rs[1] / rs[2] : rs[2] / rs[3]);
#pragma unroll
                for (int bj = 0; bj < 2; ++bj) { acc[ai][bj][m][0] *= f; acc[ai][bj][m][1] *= f; }
                if (m & 1) asm volatile("" ::: "memory"); }
    }
    __device__ __forceinline__ void operator()(const f32x4 (&acc)[2][2][4][2], const Unit& u, int ui, int wr, int wc, int fr, int fq) const {
        const bf16* gates = (const bf16*)(wsb + OFF_GATES); bf16* out = (bf16*)(wsb + OFF_K); const float* rst = (const float*)(wsb + OFF_RST);
        const int row0 = u.pm * 256 + wr * 64 + fr, col0 = u.pn * 256 + wc * 32 + 8 * fq;
        f32x4 bv[2][2];
#pragma unroll
        for (int bj = 0; bj < 2; ++bj) { bv[bj][0] = *(const f32x4*)(gb + 1024 + col0 + bj * 128); bv[bj][1] = *(const f32x4*)(gb + 1024 + col0 + bj * 128 + 4); }
#pragma unroll
        for (int ai = 0; ai < 2; ++ai)
#pragma unroll
          for (int mh = 0; mh < 4; mh += 2) {
            u32x4 gq[2][2], tq[2][2]; float r3[2];
#pragma unroll
            for (int m = 0; m < 2; ++m) { const size_t r = (size_t)(row0 + ai * 128 + (mh + m) * 16); r3[m] = rst[((size_t)u.pn * T + r) * 4 + 3];
#pragma unroll
                for (int bj = 0; bj < 2; ++bj) { gq[m][bj] = *(const u32x4*)(gates + r * 2048 + 1024 + col0 + bj * 128); tq[m][bj] = *(const u32x4*)(out + r * D + col0 + bj * 128); } }
#pragma unroll
            for (int m = 0; m < 2; ++m) { const size_t r = (size_t)(row0 + ai * 128 + (mh + m) * 16);
#pragma unroll
                for (int bj = 0; bj < 2; ++bj) { f32x4 g0, g1, t0, t1; unpack8(gq[m][bj], g0, g1); unpack8(tq[m][bj], t0, t1);
                    *(u32x4*)(out + r * D + col0 + bj * 128) = pack8(t0 + sigm4(g0 + bv[bj][0]) * r3[m] * acc[ai][bj][mh + m][0], t1 + sigm4(g1 + bv[bj][1]) * r3[m] * acc[ai][bj][mh + m][1]); } }
            asm volatile("" ::: "memory");
          }
    }
};
struct EpiOut { static constexpr bool HOOKS = false;
    const float* x; const float* mod; float* out;
    __device__ __forceinline__ void operator()(const f32x4 (&acc)[2][2][4][2], const Unit& u, int ui, int wr, int wc, int fr, int fq) const {
        const int row0 = u.pm * 256 + wr * 64 + fr, col0 = u.pn * 256 + wc * 32 + 8 * fq; const float* g1 = mod + (u.pm >> 3) * 6144 + 2 * D;
        f32x4 gv[2][2];
#pragma unroll
        for (int bj = 0; bj < 2; ++bj) { gv[bj][0] = *(const f32x4*)(g1 + col0 + bj * 128); gv[bj][1] = *(const f32x4*)(g1 + col0 + bj * 128 + 4); }
#pragma unroll
        for (int ai = 0; ai < 2; ++ai) {
            f32x4 xv[4][2][2];
#pragma unroll
            for (int m = 0; m < 4; ++m)
#pragma unroll
                for (int bj = 0; bj < 2; ++bj) { const size_t o = (size_t)(row0 + ai * 128 + m * 16) * D + col0 + bj * 128; xv[m][bj][0] = *(const f32x4*)(x + o); xv[m][bj][1] = *(const f32x4*)(x + o + 4); }
#pragma unroll
            for (int m = 0; m < 4; ++m)
#pragma unroll
                for (int bj = 0; bj < 2; ++bj) { const size_t o = (size_t)(row0 + ai * 128 + m * 16) * D + col0 + bj * 128;
                    *(f32x4*)(out + o) = xv[m][bj][0] + gv[bj][0] * acc[ai][bj][m][0]; *(f32x4*)(out + o + 4) = xv[m][bj][1] + gv[bj][1] * acc[ai][bj][m][1]; }
        }
    }
};
__device__ __forceinline__ f32x4 swiglu4(f32x4 g, f32x4 l) { f32x4 r;
#pragma unroll
    for (int i = 0; i < 4; ++i) { const float gg = fminf(g[i], 7.f), ll = fminf(fmaxf(l[i], -7.f), 7.f); r[i] = gg * sigm(1.702f * gg) * (ll + 1.f); } return r; }
struct EpiMoe1 { static constexpr bool HOOKS = false;
    const float* b1; bf16* hb;
    __device__ __forceinline__ void operator()(const f32x4 (&acc)[2][2][4][2], const Unit& u, int ui, int wr, int wc, int fr, int fq) const {
        const int j0 = u.pn * 128 + wc * 32 + 8 * fq; const float* bb = b1 + u.e * 2048 + j0;
        const f32x4 bg0 = *(const f32x4*)(bb), bg1 = *(const f32x4*)(bb + 4), bl0 = *(const f32x4*)(bb + 1024), bl1 = *(const f32x4*)(bb + 1028);
#pragma unroll
        for (int ai = 0; ai < 2; ++ai)
#pragma unroll
            for (int m = 0; m < 4; ++m) { const size_t r = (size_t)u.pm * 256 + ai * 128 + wr * 64 + m * 16 + fr;
                *(u32x4*)(hb + r * FF + j0) = pack8(swiglu4(acc[ai][0][m][0] + bg0, acc[ai][1][m][0] + bl0), swiglu4(acc[ai][0][m][1] + bg1, acc[ai][1][m][1] + bl1)); }
    }
};
struct EpiMoe2 { static constexpr bool HOOKS = false;
    const float* b2; bf16* yb; const LAS int* tabE; const LAS float* tabW;
    __device__ __forceinline__ void operator()(const f32x4 (&acc)[2][2][4][2], const Unit& u, int ui, int wr, int wc, int fr, int fq) const {
        const int col0 = u.pn * 256 + wc * 32 + 8 * fq; const float* bb = b2 + u.e * D + col0;
        f32x4 bv[2][2];
#pragma unroll
        for (int bj = 0; bj < 2; ++bj) { bv[bj][0] = *(const f32x4*)(bb + bj * 128); bv[bj][1] = *(const f32x4*)(bb + bj * 128 + 4); }
#pragma unroll
        for (int ai = 0; ai < 2; ++ai)
#pragma unroll
            for (int m = 0; m < 4; ++m) { const int r = ui * 256 + ai * 128 + wr * 64 + m * 16 + fr; const int ent = tabE[r]; const float w = tabW[r];
                if (ent >= 0) { bf16* p = yb + (size_t)ent * D + col0;
#pragma unroll
                    for (int bj = 0; bj < 2; ++bj) *(u32x4*)(p + bj * 128) = pack8((acc[ai][bj][m][0] + bv[bj][0]) * w, (acc[ai][bj][m][1] + bv[bj][1]) * w); } }
    }
};
}

namespace attn_body {
using bf16=unsigned short;
using bf16x8=__attribute__((ext_vector_type(8)))short;
using s16x4=__attribute__((ext_vector_type(4)))short;
using f32x16=__attribute__((ext_vector_type(16)))float;
constexpr int BATCH=16,NHEAD=16,SEQ=2048,D=64,DM=NHEAD*D,QP=3072;
constexpr int NW=8,QBLK=32,QB=QBLK*NW,KVBLK=64,NQB=SEQ/QB;
constexpr int ATTN_UNIT_ROWS=QB;
constexpr int YOFF=2063, TARR=2384, TARRB=TARR*4, TBL_BYTES=4*TARRB+256;
__device__ __forceinline__ int crow(int r,int hi){return (r&3)+8*(r>>2)+4*hi;}
#define SBAR() __builtin_amdgcn_sched_barrier(0)
__device__ __forceinline__ void cmask(f32x16&p0,f32x16&p1,int jb,int qrel,int hi){
  const float NEG=-INFINITY; const int lim=qrel-4*hi-64*jb;
  #pragma unroll
  for(int r=0;r<16;++r){const int c=(r&3)+8*(r>>2); if(c>lim)p0[r]=NEG; if(c+32>lim)p1[r]=NEG;}
}

constexpr int NSLOT=3, SLOTB=8192;
constexpr int LDS_K=0, LDS_V=NSLOT*SLOTB, LDS_WS=2*NSLOT*SLOTB, LDS_OST=LDS_WS+NW*64*4, LDS_TBL=LDS_OST+NW*4096, LDS_BYTES=LDS_TBL+TBL_BYTES;
__device__ __forceinline__ void glds16(const void*gsrc,unsigned lds_dst){unsigned keep;
  asm volatile("s_mov_b32 %0, m0\n\ts_mov_b32 m0, %2\n\ts_nop 0\n\tglobal_load_lds_dwordx4 %1, off\n\ts_mov_b32 m0, %0":"=&s"(keep):"v"(gsrc),"s"(lds_dst):"memory");}
__device__ __forceinline__ float max3f(float a,float b,float c){float r;asm("v_max3_f32 %0, %1, %2, %3":"=v"(r):"v"(a),"v"(b),"v"(c));return r;}
__device__ __forceinline__ float max2f(float a,float b){float r;asm("v_max_f32_e32 %0, %1, %2":"=v"(r):"v"(a),"v"(b));return r;}
__device__ __forceinline__ float fadd_s(float a,float b){float r;asm("v_add_f32_e32 %0, %1, %2":"=v"(r):"v"(a),"v"(b));return r;}
__device__ __forceinline__ float fsub_s(float a,float b){float r;asm("v_sub_f32_e32 %0, %1, %2":"=v"(r):"v"(a),"v"(b));return r;}
typedef float f32x2_t __attribute__((ext_vector_type(2))); typedef __bf16 bf16x2_t __attribute__((ext_vector_type(2)));
__device__ __forceinline__ unsigned cvtpk_s(float lo,float hi){f32x2_t v={lo,hi};bf16x2_t b=__builtin_convertvector(v,bf16x2_t);return __builtin_bit_cast(unsigned,b);}
#define WAIT_BAR(N) asm volatile("s_waitcnt vmcnt(" #N ") lgkmcnt(0)\n\ts_barrier":::"memory")

__device__ __forceinline__ void qkt(f32x16&p0,f32x16&p1,const char*Kslot,const bf16x8*qr,int r32,int hi){
  const char*kb=Kslot+hi*1024+r32*16;
  #pragma unroll
  for(int d0=0;d0<4;++d0){
    const bf16x8 b0=*reinterpret_cast<const bf16x8*>(kb+d0*2048);
    const bf16x8 b1=*reinterpret_cast<const bf16x8*>(kb+d0*2048+512);
    p0=__builtin_amdgcn_mfma_f32_32x32x16_bf16(b0,qr[d0],p0,0,0,0);p1=__builtin_amdgcn_mfma_f32_32x32x16_bf16(b1,qr[d0],p1,0,0,0);}
}
typedef __attribute__((address_space(3))) const char* lds_cptr;
typedef short v4i16_t __attribute__((ext_vector_type(4)));
__device__ __forceinline__ void kload8(bf16x8*kf,lds_cptr kp){
  kf[0]=*(const __attribute__((address_space(3))) bf16x8*)(kp);      kf[1]=*(const __attribute__((address_space(3))) bf16x8*)(kp+512);
  kf[2]=*(const __attribute__((address_space(3))) bf16x8*)(kp+2048); kf[3]=*(const __attribute__((address_space(3))) bf16x8*)(kp+2560);
  kf[4]=*(const __attribute__((address_space(3))) bf16x8*)(kp+4096); kf[5]=*(const __attribute__((address_space(3))) bf16x8*)(kp+4608);
  kf[6]=*(const __attribute__((address_space(3))) bf16x8*)(kp+6144); kf[7]=*(const __attribute__((address_space(3))) bf16x8*)(kp+6656);
}
__device__ __forceinline__ void kload2(bf16x8*kf,lds_cptr kp,int j){ kf[2*j]=*(const __attribute__((address_space(3))) bf16x8*)(kp+j*2048); kf[2*j+1]=*(const __attribute__((address_space(3))) bf16x8*)(kp+j*2048+512); }
__device__ __forceinline__ s16x4 vtr(lds_cptr p){ return __builtin_bit_cast(s16x4,__builtin_amdgcn_ds_read_tr16_b64_v4i16((__attribute__((address_space(3))) v4i16_t*)p)); }
__device__ __forceinline__ float rowmax(const f32x16&p0,const f32x16&p1){
  float a=max3f(p0[0],p0[1],p1[0]),b=max3f(p0[2],p0[3],p1[1]);a=max3f(a,p1[2],p1[3]);
  #pragma unroll
  for(int r=4;r<16;r+=4){a=max3f(a,p0[r],p0[r+1]);b=max3f(b,p0[r+2],p0[r+3]);a=max3f(a,p1[r],p1[r+1]);b=max3f(b,p1[r+2],p1[r+3]);}
  const float m=max2f(a,b);
  auto rr=__builtin_amdgcn_permlane32_swap(__float_as_uint(m),__float_as_uint(m),false,false);
  return max2f(__uint_as_float(rr[0]),__uint_as_float(rr[1]));
}
__device__ __forceinline__ void pv(f32x16*o,int vb,bf16x8 pa0,bf16x8 pa1,bf16x8 pa2,bf16x8 pa3){
  #pragma unroll
  for(int d0=0;d0<2;++d0){s16x4 lo[4],hi[4];
    #pragma unroll
    for(int ks=0;ks<4;++ks){
      asm volatile("ds_read_b64_tr_b16 %0,%1 offset:%c2":"=&v"(lo[ks]):"v"(vb),"i"(d0*4096+ks*1024):"memory");
      asm volatile("ds_read_b64_tr_b16 %0,%1 offset:%c2":"=&v"(hi[ks]):"v"(vb),"i"(d0*4096+ks*1024+512):"memory");}
    asm volatile("s_waitcnt lgkmcnt(0)":::"memory");SBAR();
    #define PK(k) (bf16x8){lo[k][0],lo[k][1],lo[k][2],lo[k][3],hi[k][0],hi[k][1],hi[k][2],hi[k][3]}
    o[d0]=__builtin_amdgcn_mfma_f32_32x32x16_bf16(pa0,PK(0),o[d0],0,0,0);
    o[d0]=__builtin_amdgcn_mfma_f32_32x32x16_bf16(pa1,PK(1),o[d0],0,0,0);
    o[d0]=__builtin_amdgcn_mfma_f32_32x32x16_bf16(pa2,PK(2),o[d0],0,0,0);
    o[d0]=__builtin_amdgcn_mfma_f32_32x32x16_bf16(pa3,PK(3),o[d0],0,0,0);
    #undef PK
  }
}

#ifndef ATTN_STORE16
#define ATTN_STORE16(p,v) (*(u32x4*)(p)=(v))
#endif
template<int THRL> __device__ __forceinline__ void attn_unit(int b,int h,int qb,const bf16*Q,const bf16*__restrict__ K,const bf16*__restrict__ V,bf16*O,const float*__restrict__ kmean,char*shm){
  const int tid=tidx(),lane=tid&63,r32=lane&31,hi=lane>>5; const int wid=__builtin_amdgcn_readfirstlane(tid>>6);
  const long rowbase=(long)b*SEQ; const int q0=qb*QB;
  const bf16*Qw=Q+(rowbase+q0+wid*QBLK)*QP+h*D;
  const bf16*Kh=K+(long)((b*NHEAD+h)*32)*4096,*Vh=V+(long)((b*NHEAD+h)*32)*4096;
  const unsigned lds0=(unsigned)(uintptr_t)shm;
  float*wsf=(float*)(shm+LDS_WS)+wid*64;
  const bf16*ksrc=Kh+(wid*64+lane)*8;
  const bf16*vsrc=Vh+(wid*64+lane)*8;
  const unsigned kdst=lds0+LDS_K+wid*1024, vdst=lds0+LDS_V+wid*1024;
  #define TMAP(t) (((t)<4)?(4*qb+(t)):((t)-4))
  #define DMA_K(t,slot) glds16(ksrc+(long)TMAP(t)*4096,(unsigned)__builtin_amdgcn_readfirstlane(kdst+(slot)))
  #define DMA_V(t,slot) glds16(vsrc+(long)TMAP(t)*4096,(unsigned)__builtin_amdgcn_readfirstlane(vdst+(slot)))
  const int vb0=(int)(lds0+LDS_V)+((lane>>4)&1)*32+(lane&3)*8+(4*hi+((lane&15)>>2))*64;
  const char*Kbase=shm+LDS_K; bf16x8 kf[8];
  const lds_cptr shm3=(lds_cptr)shm; const lds_cptr kp0=shm3+LDS_K+hi*1024+r32*16; const lds_cptr vp0=shm3+LDS_V+((lane>>4)&1)*32+(lane&3)*8+(4*hi+((lane&15)>>2))*64;
  const int NT=(q0+QB)/KVBLK;
  DMA_K(0,0);DMA_V(0,0);DMA_K(1,SLOTB);
  bf16x8 qr[4];
  #pragma unroll
  for(int d0=0;d0<4;++d0)qr[d0]=*reinterpret_cast<const bf16x8*>(&Qw[(long)r32*QP+d0*16+hi*8]);
  float mhat=0.f,l_reg=0.f;f32x16 o[2];o[0]=f32x16{};o[1]=f32x16{};
  const int qrel=wid*QBLK+r32;
  unsigned selm=0u;
  { f32x16 gacc=f32x16{};
    if(qb>0){ const float*kmn=kmean+(long)r32*NHEAD*D; asm volatile("":"+v"(kmn));
      #pragma unroll
      for(int d0=0;d0<4;++d0){ f32x4 k0={0.f,0.f,0.f,0.f},k1={0.f,0.f,0.f,0.f};
        if(r32<qb){ k0=*reinterpret_cast<const f32x4*>(kmn+d0*16+hi*8); k1=*reinterpret_cast<const f32x4*>(kmn+d0*16+hi*8+4); }
        u32x4 uh,ul; float h0,h1;
        uh.x=cvtpk_s(k0[0],k0[1]); h0=__uint_as_float(uh.x<<16); h1=__uint_as_float(uh.x&0xffff0000u); ul.x=cvtpk_s(k0[0]-h0,k0[1]-h1);
        uh.y=cvtpk_s(k0[2],k0[3]); h0=__uint_as_float(uh.y<<16); h1=__uint_as_float(uh.y&0xffff0000u); ul.y=cvtpk_s(k0[2]-h0,k0[3]-h1);
        uh.z=cvtpk_s(k1[0],k1[1]); h0=__uint_as_float(uh.z<<16); h1=__uint_as_float(uh.z&0xffff0000u); ul.z=cvtpk_s(k1[0]-h0,k1[1]-h1);
        uh.w=cvtpk_s(k1[2],k1[3]); h0=__uint_as_float(uh.w<<16); h1=__uint_as_float(uh.w&0xffff0000u); ul.w=cvtpk_s(k1[2]-h0,k1[3]-h1);
        gacc=__builtin_amdgcn_mfma_f32_32x32x16_bf16(__builtin_bit_cast(bf16x8,uh),qr[d0],gacc,0,0,0);
        gacc=__builtin_amdgcn_mfma_f32_32x32x16_bf16(__builtin_bit_cast(bf16x8,ul),qr[d0],gacc,0,0,0); } }
    float gt[8];
    #pragma unroll
    for(int i=0;i<4;++i){ const float own=gacc[i], oth=__shfl_xor(own,32); gt[i]=hi?oth:own; gt[4+i]=hi?own:oth; }
    #pragma unroll
    for(int n=0;n<8;++n) if(n>=qb) gt[n]=-INFINITY;
    #pragma unroll
    for(int n=0;n<8;++n){ int rk=0;
      #pragma unroll
      for(int m=0;m<8;++m) rk+=(m<qb&&(gt[m]>gt[n]||(gt[m]==gt[n]&&m<n)))?1:0;
      if(n<qb&&(qb<=3||rk<3)) selm|=(1u<<n); } }
  const int qabs=q0+qrel, cpy=(YOFF-qabs)&3;
  const lds_cptr tb_sel=shm3+(LDS_TBL+cpy*TARRB+4*(YOFF-qabs+4*hi-cpy)), tb_neg=shm3+(LDS_TBL+4*TARRB);
  typedef __attribute__((address_space(3))) const f32x4* lds_f4p;
  #define BIASLD(P0,P1,t) do{ const int tt_=TMAP(t); const bool on_=((t)<4)||((selm>>(tt_>>2))&1u); const lds_cptr ba_=on_?(tb_sel+256*tt_):tb_neg; \
    _Pragma("unroll") for(int g_=0;g_<4;++g_){ const f32x4 x0_=*(lds_f4p)(ba_+32*g_), x1_=*(lds_f4p)(ba_+32*g_+128); \
      _Pragma("unroll") for(int i_=0;i_<4;++i_){ P0[4*g_+i_]=x0_[i_]-mhat; P1[4*g_+i_]=x1_[i_]-mhat; } } }while(0)
  #define CMASK(P0,P1,t) do{ if((t)<4){ int qr_=qrel; asm volatile("":"+v"(qr_)); cmask(P0,P1,(t),qr_,hi); } }while(0)
  bool resc=false;
  #define START(P0,P1) do{ const float rm=rowmax(P0,P1); resc=false; \
    { const float dl=rm; mhat=fadd_s(mhat,dl); \
      _Pragma("unroll") for(int r=0;r<16;++r){P0[r]=fsub_s(P0[r],dl);P1[r]=fsub_s(P1[r],dl);} } \
    _Pragma("unroll") for(int r=0;r<16;++r)P0[r]=__builtin_amdgcn_exp2f(P0[r]); }while(0)
  #define RESC() do{ if(resc){ asm volatile("s_waitcnt lgkmcnt(0)":::"memory"); \
      _Pragma("unroll") for(int d_=0;d_<2;++d_) _Pragma("unroll") for(int r=0;r<16;++r)o[d_][r]*=wsf[crow(r,hi)]; } }while(0)
  f32x16 pA0,pA1,pB0,pB1;
  int sl_prev=0,sl_cur=0,sl_next=SLOTB;
  #define ROT() do{sl_prev=sl_cur;sl_cur=sl_next;sl_next=(sl_next==(NSLOT-1)*SLOTB)?0:sl_next+SLOTB;}while(0)
  DMA_K(2,2*SLOTB);
  WAIT_BAR(3);
  BIASLD(pA0,pA1,0); qkt(pA0,pA1,Kbase,qr,r32,hi);asm volatile("s_nop 15\n\ts_nop 7":"+v"(pA0),"+v"(pA1));CMASK(pA0,pA1,0);
  START(pA0,pA1);
  _Pragma("unroll") for(int r=0;r<16;++r)pA1[r]=__builtin_amdgcn_exp2f(pA1[r]);
  WAIT_BAR(0);
  DMA_K(3,0);DMA_V(1,SLOTB);
  ROT();
  kload8(kf,kp0+sl_cur);
  WAIT_BAR(2);
  s16x4 vlo[8],vhi[8]; u32x4 pw0,pw1,pw2,pw3;
  #define PKW(P,B) cvtpk_s(P[B],P[B+1])
  #define PAF(k) __builtin_bit_cast(bf16x8,pw##k)
  #define VFR(i) (bf16x8){vlo[i][0],vlo[i][1],vlo[i][2],vlo[i][3],vhi[i][0],vhi[i][1],vhi[i][2],vhi[i][3]}
  #define PIN(x) asm volatile("":"+v"(x))
  #define MX3(a,b,c) __builtin_fmaxf(__builtin_fmaxf((a),(b)),(c))
  #define GAPA(MF,A0,A1,A2,A3,W0,W1,PW) do{ MF; sacc+=A0; sacc+=A1; sacc+=A2; sacc+=A3; PIN(sacc); W0; W1; PIN(PW); SBAR(); }while(0)
  #define EX(v) __builtin_amdgcn_exp2f(v)
  #define GAPB(MF,X,B) do{ MF; X[B]=EX(X[B]); X[B+1]=EX(X[B+1]); X[B+2]=EX(X[B+2]); X[B+3]=EX(X[B+3]); PIN(X); SBAR(); }while(0)
  #define VRD(i) do{ vlo[i]=vtr(vp_+(((i)>>2)*4096+((i)&3)*1024)); vhi[i]=vtr(vp_+(((i)>>2)*4096+((i)&3)*1024+512)); }while(0)
  #define KRD(G,j) do{ if(G){ kload2(kf,kp0+sl_next,j); SBAR(); } }while(0)
  #define STEP(C0,C1,P0,P1,t,GK,GV,GL) do{ SBAR(); \
    BIASLD(C0,C1,t); SBAR(); \
    const lds_cptr vp_=vp0+sl_prev; \
    VRD(0); SBAR(); float sacc=(P0[0]+P0[1]); \
    GAPA(C0=__builtin_amdgcn_mfma_f32_32x32x16_bf16(kf[0],qr[0],C0,0,0,0), P0[2],P0[3],P0[4],P0[5],     pw0[0]=PKW(P0,0), pw0[1]=PKW(P0,2), pw0); \
    VRD(4); SBAR(); GAPA(C1=__builtin_amdgcn_mfma_f32_32x32x16_bf16(kf[1],qr[0],C1,0,0,0), P0[6],P0[7],P0[8],P0[9],     pw0[2]=PKW(P0,4), pw0[3]=PKW(P0,6), pw0); \
    VRD(1); SBAR(); GAPA(C0=__builtin_amdgcn_mfma_f32_32x32x16_bf16(kf[2],qr[1],C0,0,0,0),   P0[10],P0[11],P0[12],P0[13], pw1[0]=PKW(P0,8), pw1[1]=PKW(P0,10), pw1); \
    VRD(5); SBAR(); GAPA(C1=__builtin_amdgcn_mfma_f32_32x32x16_bf16(kf[3],qr[1],C1,0,0,0),   P0[14],P0[15],P1[0],P1[1],   pw1[2]=PKW(P0,12),pw1[3]=PKW(P0,14), pw1); \
    VRD(2); SBAR(); GAPA(C0=__builtin_amdgcn_mfma_f32_32x32x16_bf16(kf[4],qr[2],C0,0,0,0),   P1[2],P1[3],P1[4],P1[5],     pw2[0]=PKW(P1,0), pw2[1]=PKW(P1,2), pw2); \
    VRD(6); SBAR(); GAPA(C1=__builtin_amdgcn_mfma_f32_32x32x16_bf16(kf[5],qr[2],C1,0,0,0),   P1[6],P1[7],P1[8],P1[9],     pw2[2]=PKW(P1,4), pw2[3]=PKW(P1,6), pw2); \
    VRD(3); SBAR(); GAPA(C0=__builtin_amdgcn_mfma_f32_32x32x16_bf16(kf[6],qr[3],C0,0,0,0),   P1[10],P1[11],P1[12],P1[13], pw3[0]=PKW(P1,8), pw3[1]=PKW(P1,10), pw3); \
    VRD(7); SBAR(); GAPA(C1=__builtin_amdgcn_mfma_f32_32x32x16_bf16(kf[7],qr[3],C1,0,0,0),   P1[14],P1[15],0.f,0.f,       pw3[2]=PKW(P1,12),pw3[3]=PKW(P1,14), pw3); \
    l_reg+=sacc; \
    if(GK){DMA_K((t)+3,sl_cur);} if(GV){DMA_V((t)+1,sl_next);} \
    CMASK(C0,C1,t); \
    { float a=MX3(C0[0],C0[1],C1[0]),b=MX3(C0[2],C0[3],C1[1]); a=MX3(a,C1[2],C1[3]); \
      _Pragma("unroll") for(int r=4;r<16;r+=4){a=MX3(a,C0[r],C0[r+1]);b=MX3(b,C0[r+2],C0[r+3]);a=MX3(a,C1[r],C1[r+1]);b=MX3(b,C1[r+2],C1[r+3]);} \
      float rm=__builtin_fmaxf(a,b); { auto rr=__builtin_amdgcn_permlane32_swap(__float_as_uint(rm),__float_as_uint(rm),false,false); rm=__builtin_fmaxf(__uint_as_float(rr[0]),__uint_as_float(rr[1])); } \
      resc=false; \
      if(__builtin_expect(__any(rm>(float)THRL),0)){ const float dl=__builtin_fmaxf(rm,0.f); mhat+=dl; \
        _Pragma("unroll") for(int r=0;r<16;++r){C0[r]-=dl;C1[r]-=dl;} \
        const float f=__builtin_amdgcn_exp2f(-dl); l_reg*=f; if(hi==0)wsf[r32]=f; resc=true; } } \
    SBAR(); \
    GAPB(o[0]=__builtin_amdgcn_mfma_f32_32x32x16_bf16(PAF(0),VFR(0),o[0],0,0,0), C0,0); \
    GAPB(o[1]=__builtin_amdgcn_mfma_f32_32x32x16_bf16(PAF(0),VFR(4),o[1],0,0,0), C0,4); \
    KRD(GL,0); GAPB(o[0]=__builtin_amdgcn_mfma_f32_32x32x16_bf16(PAF(1),VFR(1),o[0],0,0,0), C0,8); \
    KRD(GL,1); GAPB(o[1]=__builtin_amdgcn_mfma_f32_32x32x16_bf16(PAF(1),VFR(5),o[1],0,0,0), C0,12); \
    KRD(GL,2); GAPB(o[0]=__builtin_amdgcn_mfma_f32_32x32x16_bf16(PAF(2),VFR(2),o[0],0,0,0), C1,0); \
    KRD(GL,3); GAPB(o[1]=__builtin_amdgcn_mfma_f32_32x32x16_bf16(PAF(2),VFR(6),o[1],0,0,0), C1,4); \
    GAPB(o[0]=__builtin_amdgcn_mfma_f32_32x32x16_bf16(PAF(3),VFR(3),o[0],0,0,0), C1,8); \
    GAPB(o[1]=__builtin_amdgcn_mfma_f32_32x32x16_bf16(PAF(3),VFR(7),o[1],0,0,0), C1,12); \
    }while(0)
  int t=1;
  for(;t+5<NT;t+=2){
    STEP(pB0,pB1,pA0,pA1,t,true,true,true);     WAIT_BAR(2); RESC(); ROT();
    STEP(pA0,pA1,pB0,pB1,t+1,true,true,true);   WAIT_BAR(2); RESC(); ROT();
  }
  #define ENDW(tt) do{ if((tt)+3<NT){WAIT_BAR(2);} else if((tt)+2<NT){WAIT_BAR(1);} else {WAIT_BAR(0);} }while(0)
  for(;t+1<NT;t+=2){
    STEP(pB0,pB1,pA0,pA1,t,(t+3<NT),(t+1<NT),(t+1<NT));       ENDW(t);   RESC(); ROT();
    STEP(pA0,pA1,pB0,pB1,t+1,(t+4<NT),(t+2<NT),(t+2<NT));     ENDW(t+1); RESC(); ROT();
  }
  STEP(pB0,pB1,pA0,pA1,NT-1,false,false,false); RESC();
  { float sacc=pB0[0]+pB0[1]; _Pragma("unroll") for(int r=2;r<16;++r)sacc+=pB0[r]; _Pragma("unroll") for(int r=0;r<16;++r)sacc+=pB1[r]; l_reg+=sacc;
    pw0=(u32x4){PKW(pB0,0),PKW(pB0,2),PKW(pB0,4),PKW(pB0,6)};pw1=(u32x4){PKW(pB0,8),PKW(pB0,10),PKW(pB0,12),PKW(pB0,14)};pw2=(u32x4){PKW(pB1,0),PKW(pB1,2),PKW(pB1,4),PKW(pB1,6)};pw3=(u32x4){PKW(pB1,8),PKW(pB1,10),PKW(pB1,12),PKW(pB1,14)};
    SBAR(); pv(o,vb0+sl_cur,PAF(0),PAF(1),PAF(2),PAF(3)); }
  #undef PKW
  #undef PAF
  #undef VFR
  #undef PIN
  #undef MX3
  #undef GAPA
  #undef GAPB
  #undef EX
  #undef VRD
  #undef KRD
  #undef STEP
  #undef ENDW
  {auto rr=__builtin_amdgcn_permlane32_swap(__float_as_uint(l_reg),__float_as_uint(l_reg),false,false);l_reg=__uint_as_float(rr[0])+__uint_as_float(rr[1]);}
  if(hi==0)wsf[32+r32]=l_reg;asm volatile("s_waitcnt lgkmcnt(0)":::"memory");
  float rli[16];
  #pragma unroll
  for(int r=0;r<16;++r)rli[r]=__builtin_amdgcn_rcpf(wsf[32+crow(r,hi)]);
  bf16*Ow=O+(rowbase+q0+wid*QBLK)*QP+h*D;
  { bf16*stg=(bf16*)(shm+LDS_OST)+wid*2048;
    #pragma unroll
    for(int r=0;r<16;++r){const int orow=crow(r,hi);
      #pragma unroll
      for(int d0=0;d0<2;++d0)stg[orow*64+d0*32+r32]=(bf16)(cvtpk_s(o[d0][r]*rli[r],0.f)&0xffffu);}
    asm volatile("s_waitcnt lgkmcnt(0)":::"memory");
    #pragma unroll
    for(int i=0;i<4;++i){const int row=i*8+(lane>>3),ch=lane&7; const u32x4 v=*(const u32x4*)(stg+row*64+ch*8); ATTN_STORE16(Ow+(long)row*QP+ch*8,v);} }
  asm volatile("s_waitcnt lgkmcnt(0)\n\ts_barrier":::"memory");
  #undef DMA_K
  #undef DMA_V
  #undef TMAP
  #undef BIASLD
  #undef CMASK
  #undef START
  #undef RESC
  #undef ROT
}
constexpr int ATTN_LDS_BYTES=LDS_BYTES;
__device__ __forceinline__ void fill_tables(char*shm,const float*__restrict__ relb){
  float*tb=(float*)(shm+LDS_TBL);
  for(int i=tidx();i<4*TARR+64;i+=512){ const int c=i/TARR, z=i-c*TARR, d=YOFF-z-c; tb[i]=(c==4)?-INFINITY:((d>=0&&d<SEQ)?relb[d]:0.f); }
}
#undef SBAR
#undef WAIT_BAR
}

namespace ssd {
typedef float f32x16 __attribute__((ext_vector_type(16)));
typedef LAS unsigned char* lptr;
constexpr int LCH = 128, NCH = SEQ / LCH;
constexpr int ROWB = 272;
constexpr size_t TILE_E = 128 * 128;
__device__ __forceinline__ int crow(int r, int hi) { return (r & 3) + 8 * (r >> 2) + 4 * hi; }
__device__ __forceinline__ unsigned pk(float lo, float hi) { return pg8::cvt_pk_bf16(lo, hi); }
__device__ __forceinline__ float bflo(unsigned w) { return __uint_as_float(w << 16); }
__device__ __forceinline__ float bfhi(unsigned w) { return __uint_as_float(w & 0xffff0000u); }

__device__ __forceinline__ void pre_unit(int unit, lptr lds, const bf16* __restrict__ brw, const bf16* __restrict__ crw, const float* __restrict__ conv_w, const float* __restrict__ conv_b,
                                         bf16* __restrict__ CBm, bf16* __restrict__ Ccg, bf16* __restrict__ BcT) {
    const int tid = tidx(), lane = tid & 63, wv = __builtin_amdgcn_readfirstlane(tid >> 6);
    const int g = unit & 3, c = (unit >> 2) & 15, b = unit >> 6;
    const size_t tbase = (size_t)unit * TILE_E;
    lptr CcL = lds, BcL = lds + 128 * ROWB;
    {
        const int arr = tid >> 8, n = tid & 127, lh = (tid >> 7) & 1;
        const bf16* src = (arr ? crw : brw) + (size_t)(b * SEQ + c * LCH) * 512 + g * 128 + n;
        const int chn = (arr ? 2560 : 2048) + g * 128 + n;
        const float w0 = conv_w[chn], w1 = conv_w[CONVD + chn], w2 = conv_w[2 * CONVD + chn], w3 = conv_w[3 * CONVD + chn], cb = conv_b[chn];
        const int l0 = lh * 64; const bool has_prev = (c > 0) || (lh > 0);
        float h0 = has_prev ? bf2f(src[(long)(l0 - 3) * 512]) : 0.f, h1 = has_prev ? bf2f(src[(long)(l0 - 2) * 512]) : 0.f, h2 = has_prev ? bf2f(src[(long)(l0 - 1) * 512]) : 0.f;
        lptr dstL = (arr ? CcL : BcL) + n * 2;
#pragma unroll 1
        for (int l8 = 0; l8 < 64; l8 += 8) {
            float v[8];
#pragma unroll
            for (int i = 0; i < 8; ++i) { const float cur = bf2f(src[(long)(l0 + l8 + i) * 512]); v[i] = siluf(cb + w0 * h0 + w1 * h1 + w2 * h2 + w3 * cur); h0 = h1; h1 = h2; h2 = cur; }
            unsigned pw[4];
#pragma unroll
            for (int i = 0; i < 4; ++i) pw[i] = pk(v[2 * i], v[2 * i + 1]);
#pragma unroll
            for (int i = 0; i < 8; ++i) *(LAS unsigned short*)(dstL + (l0 + l8 + i) * ROWB) = (unsigned short)((i & 1) ? (pw[i >> 1] >> 16) : (pw[i >> 1] & 0xffffu));
            if (arr) {
#pragma unroll
                for (int i = 0; i < 8; ++i) { const int l = l0 + l8 + i, t = n & 15;
                    Ccg[tbase + ((size_t)(((l >> 5) * 8 + (n >> 4)) * 64 + (l & 31) + 32 * ((t >> 2) & 1))) * 8 + (((t >> 3) << 2) | (t & 3))] = (bf16)((i & 1) ? (pw[i >> 1] >> 16) : (pw[i >> 1] & 0xffffu)); }
            } else { u32x4 o; o.x = pw[0]; o.y = pw[1]; o.z = pw[2]; o.w = pw[3]; const int l = l0 + l8;
                *(u32x4*)(BcT + tbase + ((size_t)(((n >> 5) * 8 + (l >> 4)) * 64 + (n & 31) + 32 * ((l >> 3) & 1))) * 8) = o; }
        }
    }
    __syncthreads();
    {
        const int r32 = lane & 31, hi = lane >> 5, rt = wv >> 1;
#pragma unroll
        for (int cc = 0; cc < 2; ++cc) {
            const int ct = 2 * (wv & 1) + cc;
            if (ct <= rt) {
                f32x16 acc = {};
#pragma unroll
                for (int ks = 0; ks < 8; ++ks) {
                    const bf16x8 a = *(const LAS bf16x8*)(CcL + (32 * rt + r32) * ROWB + (16 * ks + 8 * hi) * 2);
                    const bf16x8 bb = *(const LAS bf16x8*)(BcL + (32 * ct + r32) * ROWB + (16 * ks + 8 * hi) * 2);
                    acc = __builtin_amdgcn_mfma_f32_32x32x16_bf16(a, bb, acc, 0, 0, 0);
                }
#pragma unroll
                for (int r = 0; r < 16; ++r) { const int s = 32 * ct + r32;
                    CBm[tbase + ((size_t)((rt * 8 + (s >> 4)) * 64 + crow(r, hi) + 32 * ((s >> 3) & 1))) * 8 + (s & 7)] = f2bf(acc[r]); }
            }
        }
    }
    __syncthreads();
}

constexpr int U_XS = 0, U_ST = 64 * ROWB, STP = 136, U_HF = 2 * 64 * ROWB, U_SC = U_HF + 2 * 16384, U_BYTES = U_SC + 2 * 1536;

__device__ __forceinline__ void main_pair(int bh, lptr lds_wg, const bf16* __restrict__ cat, bf16* __restrict__ yout, float* __restrict__ ssq, const bf16* __restrict__ xs, const float* __restrict__ dtraw, const bf16* __restrict__ CBm, const bf16* __restrict__ Ccg, const bf16* __restrict__ BcT,
                                          const float* __restrict__ conv_w, const float* __restrict__ conv_b, const float* __restrict__ dt_bias, const float* __restrict__ a_log, const float* __restrict__ d_skip) {
    const int tid = tidx(), lane = tid & 63, wave = __builtin_amdgcn_readfirstlane(tid >> 6), w = wave & 3, un = wave >> 2, lt = tid & 255;
    const int r32 = lane & 31, hi = lane >> 5;
    const int h = bh & 31, b = bh >> 5, g = h >> 3;
    lptr L = lds_wg + un * U_BYTES;
    const float A2 = -__expf(a_log[h]) * LOG2E, dtb = dt_bias[h], dsk = d_skip[h];
    const int cp = lt & 63;
    f32x16 Hs[2]; Hs[0] = f32x16{}; Hs[1] = f32x16{};
    const int oR = (32 * w + (lane >> 3)) * CATP + h * 64 + 8 * (lane & 7), oX = (32 * w - 3) * SI + h * 64 + cp;
    float dr0 = 0.f, dr1 = 0.f;
#define SSD_PREF(cn) do { const size_t t0_ = (size_t)b * SEQ + (size_t)(cn) * LCH; if (w == 0) { dr0 = dtraw[(t0_ + 2 * lane) * 32 + h]; dr1 = dtraw[(t0_ + 2 * lane + 1) * 32 + h]; } } while (0)
    SSD_PREF(0);
    for (int c = 0; c < NCH; ++c) {
        const size_t tok0 = (size_t)b * SEQ + (size_t)c * LCH;
        const size_t tbase = ((size_t)(b * NCH + c) * 4 + g) * TILE_E;
        LAS float* SC = (LAS float*)(L + U_SC + (c & 1) * 1536);
        u32x4 cbf[8]; u32x2 ccf[16]; u32x4 zq[4]; unsigned short rawx[35];
        const float* cwp = conv_w + h * 64; const float* cbp_ = conv_b + h * 64; asm volatile("" : "+s"(cwp), "+s"(cbp_));
        const float cw0 = cwp[cp], cw1 = cwp[CONVD + cp], cw2 = cwp[2 * CONVD + cp], cw3 = cwp[3 * CONVD + cp], cbias = cbp_[cp];
        { const bf16* xb_ = xs + tok0 * SI; const bool hp_ = (c > 0) || (w > 0); int ox_ = oX;
#pragma unroll
          for (int i_ = 0; i_ < 35; ++i_) { rawx[i_] = (i_ >= 3 || hp_) ? xb_[ox_] : (unsigned short)0; ox_ += SI; asm volatile("" : "+v"(ox_)); } }
        { const bf16* cbb = CBm + tbase;
#pragma unroll
          for (int ks = 0; ks < 8; ++ks) cbf[ks] = (ks < 2 * w + 2) ? *(const u32x4*)(cbb + ((w * 8 + ks) * 64 + lane) * 8) : (u32x4){0u, 0u, 0u, 0u};
          if (c > 0) { const bf16* ccb = Ccg + tbase;
#pragma unroll
              for (int q = 0; q < 8; ++q) { const u32x4 t_ = *(const u32x4*)(ccb + ((w * 8 + q) * 64 + lane) * 8); ccf[2 * q].x = t_.x; ccf[2 * q].y = t_.y; ccf[2 * q + 1].x = t_.z; ccf[2 * q + 1].y = t_.w; } }
        }
        if (w == 0) {
            const float d0 = softplus_fast(dr0 + dtb), d1 = softplus_fast(dr1 + dtb);
            const float a0 = d0 * A2, a1 = d1 * A2; float s = a0 + a1;
#pragma unroll
            for (int o = 1; o < 64; o <<= 1) { const float t = __shfl_up(s, o); if (lane >= o) s += t; }
            const float aend_ = __shfl(s, 63);
            SC[2 * lane] = s - a1; SC[2 * lane + 1] = s; SC[128 + 2 * lane] = (s - a1) - __builtin_amdgcn_logf(d0); SC[129 + 2 * lane] = s - __builtin_amdgcn_logf(d1);
            SC[256 + 2 * lane] = d0 * __builtin_amdgcn_exp2f(aend_ - (s - a1)); SC[257 + 2 * lane] = d1 * __builtin_amdgcn_exp2f(aend_ - s);
        }
        __syncthreads();
        {
            float h0 = bf2f(rawx[0]), h1 = bf2f(rawx[1]), h2 = bf2f(rawx[2]);
#pragma unroll
            for (int l8 = 0; l8 < 32; l8 += 8) {
                float v[8];
#pragma unroll
                for (int i = 0; i < 8; ++i) { const float cur = bf2f(rawx[3 + l8 + i]); v[i] = silu_fast(cbias + cw0 * h0 + cw1 * h1 + cw2 * h2 + cw3 * cur); h0 = h1; h1 = h2; h2 = cur; }
                u32x4 o0; o0.x = pk(v[0], v[1]); o0.y = pk(v[2], v[3]); o0.z = pk(v[4], v[5]); o0.w = pk(v[6], v[7]);
                *(LAS u32x4*)(L + U_XS + cp * ROWB + (32 * w + l8) * 2) = o0;
            }
        }
        if (c + 1 < NCH) SSD_PREF(c + 1);
        __syncthreads();
        f32x16 Y[2]; Y[0] = f32x16{}; Y[1] = f32x16{};
        if (c > 0) {
            lptr HFr = L + U_HF + ((c - 1) & 1) * 16384;
#pragma unroll
            for (int wb = 0; wb < 4; ++wb)
#pragma unroll
                for (int s = 0; s < 2; ++s) {
                    u32x4 au; au.x = ccf[2 * (2 * wb + s)].x; au.y = ccf[2 * (2 * wb + s)].y; au.z = ccf[2 * (2 * wb + s) + 1].x; au.w = ccf[2 * (2 * wb + s) + 1].y; const bf16x8 cfr = __builtin_bit_cast(bf16x8, au);
#pragma unroll
                    for (int pb = 0; pb < 2; ++pb) { const bf16x8 hb = *(const LAS bf16x8*)(HFr + (((wb * 2 + pb) * 2 + s) * 64 + lane) * 16); Y[pb] = __builtin_amdgcn_mfma_f32_32x32x16_bf16(hb, cfr, Y[pb], 0, 0, 0); }
                    __builtin_amdgcn_sched_barrier(0);
                }
            const float e = __builtin_amdgcn_exp2f(SC[32 * w + r32]);
#pragma unroll
            for (int r = 0; r < 16; ++r) { Y[0][r] *= e; Y[1][r] *= e; }
        }
        { const bf16* zb = cat + tok0 * CATP + 1024;
#pragma unroll
          for (int i = 0; i < 4; ++i) zq[i] = *(const u32x4*)(zb + (oR + 8 * i * CATP)); }
        u32x4 btf[8];
        { const bf16* bb = BcT + tbase;
#pragma unroll
          for (int ks = 0; ks < 8; ++ks) btf[ks] = *(const u32x4*)(bb + ((w * 8 + ks) * 64 + lane) * 8); }
        {
            const float al = SC[32 * w + r32];
#pragma unroll
            for (int ks = 0; ks < 8; ++ks) if (ks < 2 * w + 2) {
                const u32x4 cu = cbf[ks];
                const f32x4 q0 = *(const LAS f32x4*)(SC + 128 + 16 * ks + 8 * hi), q1 = *(const LAS f32x4*)(SC + 128 + 16 * ks + 8 * hi + 4);
                float m[8];
                m[0] = bflo(cu.x) * __builtin_amdgcn_exp2f(al - q0[0]); m[1] = bfhi(cu.x) * __builtin_amdgcn_exp2f(al - q0[1]); m[2] = bflo(cu.y) * __builtin_amdgcn_exp2f(al - q0[2]); m[3] = bfhi(cu.y) * __builtin_amdgcn_exp2f(al - q0[3]);
                m[4] = bflo(cu.z) * __builtin_amdgcn_exp2f(al - q1[0]); m[5] = bfhi(cu.z) * __builtin_amdgcn_exp2f(al - q1[1]); m[6] = bflo(cu.w) * __builtin_amdgcn_exp2f(al - q1[2]); m[7] = bfhi(cu.w) * __builtin_amdgcn_exp2f(al - q1[3]);
                if (ks >= 2 * w) {
                    int dd = r32 - (16 * ks + 8 * hi - 32 * w); asm volatile("" : "+v"(dd));
#pragma unroll
                    for (int j = 0; j < 8; ++j) { if (j > dd) m[j] = 0.f; if (j == dd) m[j] += dsk; }
                }
                u32x4 mu; mu.x = pk(m[0], m[1]); mu.y = pk(m[2], m[3]); mu.z = pk(m[4], m[5]); mu.w = pk(m[6], m[7]); const bf16x8 mf = __builtin_bit_cast(bf16x8, mu);
#pragma unroll
                for (int pb = 0; pb < 2; ++pb) { const bf16x8 xb = *(const LAS bf16x8*)(L + U_XS + (32 * pb + r32) * ROWB + (16 * ks + 8 * hi) * 2); Y[pb] = __builtin_amdgcn_mfma_f32_32x32x16_bf16(xb, mf, Y[pb], 0, 0, 0); }
                __builtin_amdgcn_sched_barrier(0);
            }
        }
        {
            lptr ST = L + U_ST + 32 * w * STP;
#pragma unroll
            for (int i = 0; i < 4; ++i) { lptr p_ = ST + (8 * i + (lane >> 3)) * STP + 16 * (lane & 7); u32x2 a_, b_; a_.x = zq[i].x; a_.y = zq[i].y; b_.x = zq[i].z; b_.y = zq[i].w; *(LAS u32x2*)p_ = a_; *(LAS u32x2*)(p_ + 8) = b_; }
            asm volatile("s_waitcnt lgkmcnt(0)" ::: "memory");
            float sq = 0.f; lptr rowp = ST + r32 * STP + 8 * hi;
#pragma unroll
            for (int pb = 0; pb < 2; ++pb)
#pragma unroll
                for (int gq = 0; gq < 4; ++gq) { const u32x2 zz = *(const LAS u32x2*)(rowp + 64 * pb + 16 * gq); u32x2 o;
                    const float y0 = Y[pb][4 * gq] * silu_fast(bflo(zz.x)), y1 = Y[pb][4 * gq + 1] * silu_fast(bfhi(zz.x)), y2 = Y[pb][4 * gq + 2] * silu_fast(bflo(zz.y)), y3 = Y[pb][4 * gq + 3] * silu_fast(bfhi(zz.y));
                    sq += (y0 * y0 + y1 * y1) + (y2 * y2 + y3 * y3); o.x = pk(y0, y1); o.y = pk(y2, y3);
                    *(LAS u32x2*)(rowp + 64 * pb + 16 * gq) = o; }
            sq += __shfl_xor(sq, 32);
            if (hi == 0) (ssq + tok0 * 32)[(32 * w + r32) * 32 + h] = sq;
            asm volatile("s_waitcnt lgkmcnt(0)" ::: "memory");
            bf16* yb_ = yout + tok0 * CATP + 1024;
#pragma unroll
            for (int i = 0; i < 4; ++i) { const lptr p_ = ST + (8 * i + (lane >> 3)) * STP + 16 * (lane & 7); const u32x2 a_ = *(const LAS u32x2*)p_, b_ = *(const LAS u32x2*)(p_ + 8);
                u32x4 o; o.x = a_.x; o.y = a_.y; o.z = b_.x; o.w = b_.y; *(u32x4*)(yb_ + (oR + 8 * i * CATP)) = o; }
        }
        {
            const float dec = __builtin_amdgcn_exp2f(SC[127]);
#pragma unroll
            for (int r = 0; r < 16; ++r) { Hs[0][r] *= dec; Hs[1][r] *= dec; }
#pragma unroll
            for (int ks = 0; ks < 8; ++ks) {
                const f32x4 f0 = *(const LAS f32x4*)(SC + 256 + 16 * ks + 8 * hi), f1 = *(const LAS f32x4*)(SC + 256 + 16 * ks + 8 * hi + 4);
                const u32x4 bu = btf[ks]; u32x4 au;
                au.x = pk(bflo(bu.x) * f0[0], bfhi(bu.x) * f0[1]); au.y = pk(bflo(bu.y) * f0[2], bfhi(bu.y) * f0[3]); au.z = pk(bflo(bu.z) * f1[0], bfhi(bu.z) * f1[1]); au.w = pk(bflo(bu.w) * f1[2], bfhi(bu.w) * f1[3]);
                const bf16x8 a = __builtin_bit_cast(bf16x8, au);
#pragma unroll
                for (int pb = 0; pb < 2; ++pb) { const bf16x8 xb = *(const LAS bf16x8*)(L + U_XS + (32 * pb + r32) * ROWB + (16 * ks + 8 * hi) * 2); Hs[pb] = __builtin_amdgcn_mfma_f32_32x32x16_bf16(a, xb, Hs[pb], 0, 0, 0); }
                __builtin_amdgcn_sched_barrier(0);
            }
            if (c + 1 < NCH) {
                lptr HFw = L + U_HF + (c & 1) * 16384;
#pragma unroll
                for (int pb = 0; pb < 2; ++pb)
#pragma unroll
                    for (int s = 0; s < 2; ++s) { u32x4 f; f.x = pk(Hs[pb][8 * s], Hs[pb][8 * s + 1]); f.y = pk(Hs[pb][8 * s + 2], Hs[pb][8 * s + 3]); f.z = pk(Hs[pb][8 * s + 4], Hs[pb][8 * s + 5]); f.w = pk(Hs[pb][8 * s + 6], Hs[pb][8 * s + 7]);
                        *(LAS u32x4*)(HFw + (((w * 2 + pb) * 2 + s) * 64 + lane) * 16) = f; }
            }
        }
    }
#undef SSD_PREF
    __syncthreads();
}
}

constexpr int CW_BAR = 4096;
#define RLX_AGENT __ATOMIC_RELAXED, __HIP_MEMORY_SCOPE_AGENT
#define LDS_WAIT() asm volatile("s_waitcnt lgkmcnt(0)" ::: "memory")
#define VM_WAIT() asm volatile("s_waitcnt vmcnt(0)" ::: "memory")
#define XB_TMO      128
#define XB_XCNT(j)  (256  + 64 * (j))
#define XB_XSUB(j)  (1280 + 64 * (j))
#define XB_XGEN(j)  (2304 + 64 * (j))
#define XB_TOP      3328
#define XB_TOPGEN   3392
#define XCD_BAR_WORDS 3456
#define XB_SPIN_CAP (1u << 27)
__device__ __forceinline__ unsigned xb_ld(unsigned* p)              { return __hip_atomic_load(p, __ATOMIC_RELAXED, __HIP_MEMORY_SCOPE_AGENT); }
__device__ __forceinline__ unsigned xb_add(unsigned* p, unsigned v) { return __hip_atomic_fetch_add(p, v, __ATOMIC_RELAXED, __HIP_MEMORY_SCOPE_AGENT); }
__device__ __forceinline__ unsigned xb_xcc_id() { return (unsigned)__builtin_amdgcn_s_getreg((3 << 11) | 20) & 0xFu; }
#define XB_SPIN(cond, bar) do { unsigned _sp = 0; while (cond) { __builtin_amdgcn_s_sleep(1); \
    if ((++_sp & 255u) == 0u) { if (xb_ld(&(bar)[XB_TMO])) break; if (_sp > XB_SPIN_CAP) { atomicAdd(&(bar)[XB_TMO], 1u); break; } } } } while (0)
struct XcdBarrier { unsigned* bar; unsigned x; volatile LAS unsigned* st; };
__device__ __forceinline__ XcdBarrier xcd_barrier_post(unsigned* bar, volatile LAS unsigned* st) {
    XcdBarrier b; b.bar = bar; b.x = xb_xcc_id(); b.st = st;
    if (tidx() == 0) (void)xb_add(&bar[XB_XCNT(b.x)], 1u);
    return b;
}
__device__ __forceinline__ void xcd_barrier_complete(unsigned* bar, unsigned x, unsigned& nloc, unsigned& nx) {
    const unsigned G = gridDim.x * gridDim.y * gridDim.z;
    unsigned sum, cnt, mine, sp = 0u;
    for (;;) {
        sum = 0u; cnt = 0u; mine = 0u;
#pragma unroll
        for (unsigned j = 0; j < 16; ++j) { const unsigned c = xb_ld(&bar[XB_XCNT(j)]); sum += c; cnt += (c > 0u) ? 1u : 0u; mine = (j == x) ? c : mine; }
        if (sum == G) break;
        __builtin_amdgcn_s_sleep(1);
        if ((++sp & 255u) == 0u) { if (xb_ld(&bar[XB_TMO])) break; if (sp > XB_SPIN_CAP) { atomicAdd(&bar[XB_TMO], 1u); break; } }
    }
    nloc = mine > 0u ? mine : 1u; nx = cnt > 0u ? cnt : 1u;
}
__device__ __forceinline__ void xcd_barrier(const XcdBarrier& b) {
    asm volatile("s_waitcnt vmcnt(0)" ::: "memory");
    __syncthreads();
    if (tidx() == 0) {
        unsigned* bar = b.bar;
        __builtin_amdgcn_s_waitcnt(0);
        unsigned nloc = b.st[0], nx = b.st[1];
        if (nloc == 0u) { xcd_barrier_complete(bar, b.x, nloc, nx); b.st[0] = nloc; b.st[1] = nx; }
        const unsigned old = xb_add(&bar[XB_XSUB(b.x)], 1u);
        const unsigned gen = old / nloc;
        if (old + 1u == (gen + 1u) * nloc) {
            __builtin_amdgcn_fence(__ATOMIC_RELEASE, "agent");
            asm volatile("s_waitcnt vmcnt(0)" ::: "memory");
            const unsigned og = xb_add(&bar[XB_TOP], 1u);
            const unsigned tg = og / nx;
            if (og + 1u == (tg + 1u) * nx) xb_add(&bar[XB_TOPGEN], 1u);
            else XB_SPIN(xb_ld(&bar[XB_TOPGEN]) == tg, bar);
            __builtin_amdgcn_fence(__ATOMIC_ACQUIRE, "agent");
            xb_add(&bar[XB_XGEN(b.x)], 1u);
            asm volatile("s_waitcnt vmcnt(0)" ::: "memory");
        } else {
            XB_SPIN(xb_ld(&bar[XB_XGEN(b.x)]) == gen, bar);
            __builtin_amdgcn_fence(__ATOMIC_ACQUIRE, "agent");
            asm volatile("s_waitcnt vmcnt(0)" ::: "memory");
        }
    }
    __syncthreads();
}

__device__ __forceinline__ void p0_transpose_item(const float* W, int K, int Nsrc, int lcol0, bf16* WT, int n0, int k0, const float* kscale, LAS float* scr, int lane) {
    {
        const int c4 = lane & 7; f32x4 v[8];
#pragma unroll
        for (int i = 0; i < 8; ++i) { const int kk = 8 * i + (lane >> 3); v[i] = (f32x4){0.f, 0.f, 0.f, 0.f}; if (lcol0 >= 0) { v[i] = *(const f32x4*)(W + (size_t)(k0 + kk) * Nsrc + lcol0 + 4 * c4); if (kscale) v[i] = v[i] * kscale[k0 + kk]; } }
#pragma unroll
        for (int i = 0; i < 8; ++i) { const int kk = 8 * i + (lane >> 3); LAS float* d = scr + kk * 33 + 4 * c4; d[0] = v[i][0]; d[1] = v[i][1]; d[2] = v[i][2]; d[3] = v[i][3]; }
    }
    LDS_WAIT(); asm volatile("" ::: "memory");
    const int c = lane & 7;
#pragma unroll
    for (int j = 0; j < 4; ++j) { const int n = (lane >> 3) + 8 * j; const LAS float* s = scr + (8 * c) * 33 + n;
        u32x4 o; o.x = pg8::cvt_pk_bf16(s[0 * 33], s[1 * 33]); o.y = pg8::cvt_pk_bf16(s[2 * 33], s[3 * 33]); o.z = pg8::cvt_pk_bf16(s[4 * 33], s[5 * 33]); o.w = pg8::cvt_pk_bf16(s[6 * 33], s[7 * 33]);
        *(u32x4*)(WT + (size_t)(n0 + n) * K + k0 + 8 * c) = o; }
    LDS_WAIT(); asm volatile("" ::: "memory");
}


__device__ __forceinline__ void router_block(int rb, LAS unsigned char* lds, const float* __restrict__ x1, const float* __restrict__ g2, const float* __restrict__ modp, const float* __restrict__ rw, const float* __restrict__ rbias,
                                             bf16* __restrict__ u2p, unsigned* __restrict__ ctlp, int* __restrict__ listp, float* __restrict__ topkwp) {
    typedef float f32x16 __attribute__((ext_vector_type(16)));
    const int tid = tidx(), lane = tid & 63, wv = __builtin_amdgcn_readfirstlane(tid >> 6), r32 = lane & 31, hi = lane >> 5;
    const int row0 = rb * 128, b = row0 >> 11;
    const float* shift = modp + b * 6144 + 3 * D, *scale = modp + b * 6144 + 4 * D;
    LAS float* CV = (LAS float*)(lds + 135168);
    LAS unsigned* LCNT = (LAS unsigned*)(CV + 448);
    if (tid < 64) LCNT[tid] = 0u;
    constexpr int XP = 132;
    LAS float* XT = (LAS float*)(lds + wv * 16896);
    bf16x8 bh[8], bl[8]; float cpart = 0.f;
#pragma unroll
    for (int ks = 0; ks < 8; ++ks) { unsigned ph[4], pl[4];
#pragma unroll
        for (int j2 = 0; j2 < 4; ++j2) { float wv2[2], hv[2];
#pragma unroll
            for (int q = 0; q < 2; ++q) { const int k = 128 * wv + 16 * ks + 8 * hi + 2 * j2 + q; const float rwv = rw[(size_t)k * NE + r32]; cpart += shift[k] * rwv; wv2[q] = g2[k] * (1.f + scale[k]) * rwv; }
            ph[j2] = pg8::cvt_pk_bf16(wv2[0], wv2[1]); hv[0] = __uint_as_float(ph[j2] << 16); hv[1] = __uint_as_float(ph[j2] & 0xffff0000u); pl[j2] = pg8::cvt_pk_bf16(wv2[0] - hv[0], wv2[1] - hv[1]); }
        u32x4 uh, ul; uh.x = ph[0]; uh.y = ph[1]; uh.z = ph[2]; uh.w = ph[3]; ul.x = pl[0]; ul.y = pl[1]; ul.z = pl[2]; ul.w = pl[3]; bh[ks] = __builtin_bit_cast(bf16x8, uh); bl[ks] = __builtin_bit_cast(bf16x8, ul); }
    cpart += __shfl_xor(cpart, 32);
    if (hi == 0) CV[wv * NE + r32] = cpart;
    f32x16 acc[4]; float ssq[4];
#pragma unroll
    for (int rt = 0; rt < 4; ++rt) {
        acc[rt] = f32x16{};
        const float* src = x1 + (size_t)(row0 + 32 * rt) * D + 128 * wv;
#pragma unroll 1
        for (int i4 = 0; i4 < 16; i4 += 4) { f32x4 v[4];
#pragma unroll
            for (int i = 0; i < 4; ++i) { const int id = (i4 + i) * 64 + lane; v[i] = *(const f32x4*)(src + (size_t)(id >> 5) * D + 4 * (id & 31)); }
#pragma unroll
            for (int i = 0; i < 4; ++i) { const int id = (i4 + i) * 64 + lane; *(LAS f32x4*)(XT + (id >> 5) * XP + 4 * (id & 31)) = v[i]; } }
        asm volatile("s_waitcnt lgkmcnt(0)" ::: "memory");
        float s = 0.f;
#pragma unroll
        for (int ks = 0; ks < 8; ++ks) {
            const f32x4 a0 = *(const LAS f32x4*)(XT + r32 * XP + 16 * ks + 8 * hi), a1 = *(const LAS f32x4*)(XT + r32 * XP + 16 * ks + 8 * hi + 4);
            s += (a0[0] * a0[0] + a0[1] * a0[1]) + (a0[2] * a0[2] + a0[3] * a0[3]) + (a1[0] * a1[0] + a1[1] * a1[1]) + (a1[2] * a1[2] + a1[3] * a1[3]);
            u32x4 uh, ul; float h0, h1;
            uh.x = pg8::cvt_pk_bf16(a0[0], a0[1]); h0 = __uint_as_float(uh.x << 16); h1 = __uint_as_float(uh.x & 0xffff0000u); ul.x = pg8::cvt_pk_bf16(a0[0] - h0, a0[1] - h1);
            uh.y = pg8::cvt_pk_bf16(a0[2], a0[3]); h0 = __uint_as_float(uh.y << 16); h1 = __uint_as_float(uh.y & 0xffff0000u); ul.y = pg8::cvt_pk_bf16(a0[2] - h0, a0[3] - h1);
            uh.z = pg8::cvt_pk_bf16(a1[0], a1[1]); h0 = __uint_as_float(uh.z << 16); h1 = __uint_as_float(uh.z & 0xffff0000u); ul.z = pg8::cvt_pk_bf16(a1[0] - h0, a1[1] - h1);
            uh.w = pg8::cvt_pk_bf16(a1[2], a1[3]); h0 = __uint_as_float(uh.w << 16); h1 = __uint_as_float(uh.w & 0xffff0000u); ul.w = pg8::cvt_pk_bf16(a1[2] - h0, a1[3] - h1);
            const bf16x8 ah = __builtin_bit_cast(bf16x8, uh), al = __builtin_bit_cast(bf16x8, ul);
            acc[rt] = __builtin_amdgcn_mfma_f32_32x32x16_bf16(ah, bh[ks], acc[rt], 0, 0, 0);
            acc[rt] = __builtin_amdgcn_mfma_f32_32x32x16_bf16(al, bh[ks], acc[rt], 0, 0, 0);
            acc[rt] = __builtin_amdgcn_mfma_f32_32x32x16_bf16(ah, bl[ks], acc[rt], 0, 0, 0);
        }
        ssq[rt] = s + __shfl_xor(s, 32);
        asm volatile("s_waitcnt lgkmcnt(0)" ::: "memory");
    }
    __syncthreads();
    {
        LAS float* P = (LAS float*)lds + (size_t)wv * 128 * 33;
#pragma unroll
        for (int rt = 0; rt < 4; ++rt) {
#pragma unroll
            for (int r = 0; r < 16; ++r) P[(32 * rt + (r & 3) + 8 * (r >> 2) + 4 * hi) * 33 + r32] = acc[rt][r];
            if (hi == 0) P[(32 * rt + r32) * 33 + 32] = ssq[rt]; }
    }
    __syncthreads();
    if (tid < NE) { float s = rbias[tid];
#pragma unroll
        for (int q = 0; q < 8; ++q) s += CV[q * NE + tid];
        CV[256 + tid] = s; }
    __syncthreads();
    if (tid < 128) {
        const LAS float* P = (const LAS float*)lds + tid * 33;
        float lg[NE]; float sq = 0.f;
#pragma unroll
        for (int e = 0; e < NE; ++e) lg[e] = 0.f;
#pragma unroll
        for (int q = 0; q < 8; ++q) {
#pragma unroll
            for (int e = 0; e < NE; ++e) lg[e] += P[q * 128 * 33 + e];
            sq += P[q * 128 * 33 + 32]; }
        const float rs = rsqrtf(sq * (1.f / D) + EPS);
        CV[320 + tid] = rs;
#pragma unroll
        for (int e = 0; e < NE; ++e) lg[e] = lg[e] * rs + CV[256 + e];
        unsigned taken = 0u; int te[4]; float tl[4];
#pragma unroll
        for (int k = 0; k < 4; ++k) { float best = -INFINITY; int bi = 0;
#pragma unroll
            for (int e = 0; e < NE; ++e) { const float cand = ((taken >> e) & 1u) ? -INFINITY : lg[e]; if (cand > best) { best = cand; bi = e; } }
            taken |= 1u << bi; te[k] = bi; tl[k] = best; }
        const float w1 = __expf(tl[1] - tl[0]), w2 = __expf(tl[2] - tl[0]), w3 = __expf(tl[3] - tl[0]), inv = 1.f / ((1.f + w1) + (w2 + w3));
        const float wk[4] = {inv, w1 * inv, w2 * inv, w3 * inv};
        const int row = row0 + tid;
        unsigned lr[4];
#pragma unroll
        for (int k = 0; k < 4; ++k) lr[k] = __hip_atomic_fetch_add(LCNT + te[k], 1u, __ATOMIC_RELAXED, __HIP_MEMORY_SCOPE_WORKGROUP);
        __syncthreads();
        if (tid < NE) LCNT[32 + tid] = atomicAdd(&ctlp[CW_COUNTS + tid], LCNT[tid]);
        __syncthreads();
#pragma unroll
        for (int k = 0; k < 4; ++k) { listp[te[k] * LISTCAP + LCNT[32 + te[k]] + lr[k]] = row * 4 + k; topkwp[row * 4 + k] = wk[k]; }
    } else { __syncthreads(); __syncthreads(); }
    __syncthreads();
    for (int r = wv; r < 128; r += NWAVES) {
        const float rs = CV[320 + r]; const size_t ro = (size_t)(row0 + r) * D;
#pragma unroll
        for (int j = 0; j < 4; ++j) { const int col = 4 * lane + 256 * j; const f32x4 v = *(const f32x4*)(x1 + ro + col), gg = *(const f32x4*)(g2 + col), sc = *(const f32x4*)(scale + col), sh = *(const f32x4*)(shift + col);
            const f32x4 o = v * rs * gg * (sc + 1.f) + sh; u32x2 w; w.x = pg8::cvt_pk_bf16(o[0], o[1]); w.y = pg8::cvt_pk_bf16(o[2], o[3]); *(u32x2*)(u2p + ro + col) = w; }
    }
    __syncthreads();
}

struct Args { const float* in[26]; float* out; unsigned char* ws; int ph_lo, ph_hi, li, pad; };
constexpr int WGM_INPROJ = 6, WGM_MRG = 4, WGM_MOE1 = 4, WGM_MOE2 = 4;
enum { PH_PRO = 0, PH_NORM1, PH_INPROJ, PH_MIX1, PH_MIX2, PH_GNORM, PH_MRGA, PH_MRGB, PH_OUT, PH_ROUTER, PH_MOE1, PH_MOE2, PH_FINAL, PH_COUNT };

__global__ void __launch_bounds__(NWAVES * 64, 2) mega(Args args_unused) {
    typedef const __attribute__((address_space(4))) Args* ArgP;
    ArgP ap = (ArgP)__builtin_amdgcn_kernarg_segment_ptr();
    asm volatile("" : "+s"(ap));
    extern __shared__ __attribute__((aligned(16))) unsigned char lds_raw[];
    LAS unsigned char* lds = (LAS unsigned char*)lds_raw;
    volatile LAS int* LCTL = (volatile LAS int*)(lds + LCTL_OFF);
    const int G = gridDim.x, bx = blockIdx.x, NGW = G * NWAVES;
#define PHASE_IDS() const int tid = tidx(), lane = tid & 63, wave = __builtin_amdgcn_readfirstlane(tid >> 6), gw = bx * NWAVES + wave; (void)tid; (void)lane; (void)wave; (void)gw
#define ws (ap->ws)
#define ctl ((unsigned*)(ws + OFF_CTL))
#define xin (ap->in[0])
#define out (ap->out)
#define mod ((float*)(ws + OFF_MOD))
#define relb ((float*)(ws + OFF_RELB))
#define kmean ((float*)(ws + OFF_KMEAN))
#define topkw ((float*)(ws + OFF_TOPKW))
#define list ((int*)(ws + OFF_LIST))
#define dtraw ((float*)(ws + OFF_DTRAW))
#define WinT ((bf16*)(ws + OFF_WIN))
#define WaT ((bf16*)(ws + OFF_WA))
#define WsT ((bf16*)(ws + OFF_WS))
#define WoT ((bf16*)(ws + OFF_WO))
#define W1T ((bf16*)(ws + OFF_W1))
#define W2T ((bf16*)(ws + OFF_W2))
#define ub ((bf16*)(ws + OFF_U))
#define cat ((bf16*)(ws + OFF_CAT))
#define kb ((bf16*)(ws + OFF_K))
#define vb ((bf16*)(ws + OFF_V))
#define xs ((bf16*)(ws + OFF_XS))
#define brw ((bf16*)(ws + OFF_BR))
#define crw ((bf16*)(ws + OFF_CR))
#define gates ((bf16*)(ws + OFF_GATES))
#define u2 ((bf16*)(ws + OFF_U2))
#define hb ((bf16*)(ws + OFF_HB))
#define yb ((bf16*)(ws + OFF_YB))
#define merged kb
    {
        const int t0 = (int)__builtin_amdgcn_workitem_id_x();
        for (int i = t0; i < (LDS_BYTES - LCTL_OFF) / 4; i += NWAVES * 64) ((LAS unsigned*)(lds + LCTL_OFF))[i] = 0u;
        __syncthreads();
        if ((t0 & 63) == 0) LCTL[192 + hw_wave_slot()] = t0 >> 6;
        __syncthreads();
    }
    const int lo = ap->ph_lo, hi = ap->ph_hi;
    XcdBarrier bar; bar.bar = ctl + CW_BAR + ap->li * XCD_BAR_WORDS; bar.x = 0; bar.st = nullptr;
    if (hi - lo > 1) bar = xcd_barrier_post(ctl + CW_BAR + ap->li * XCD_BAR_WORDS, (volatile LAS unsigned*)(LCTL + 128));
#define IN(k) (lo <= (k) && (k) < hi)
#define SEAM(k) do { if (IN(k) && IN((k) + 1)) xcd_barrier(bar); } while (0)

    if (IN(PH_PRO)) {
        PHASE_IDS();
        const float* c = ap->in[1]; const float* ada_w = ap->in[2]; const float* ada_b = ap->in[3];
        const int gt = bx * (NWAVES * 64) + tid;
        {
            const int b0 = (bx * (NWAVES * 64)) / 6144; LAS float* cs = (LAS float*)lds;
            for (int i = tid; i < 2 * D; i += NWAVES * 64) { const int bb = b0 + (i >> 10); cs[i] = bb < NBATCH ? siluf(c[bb * D + (i & 1023)]) : 0.f; }
            __syncthreads();
            if (gt < NBATCH * 6144) { const int j = gt % 6144, b = gt / 6144; const LAS float* cb = cs + (b - b0) * D; float a0 = 0.f, a1 = 0.f, a2 = 0.f, a3 = 0.f;
#pragma unroll 4
                for (int k = 0; k < D; k += 4) { a0 += cb[k] * ada_w[(size_t)k * 6144 + j]; a1 += cb[k + 1] * ada_w[(size_t)(k + 1) * 6144 + j]; a2 += cb[k + 2] * ada_w[(size_t)(k + 2) * 6144 + j]; a3 += cb[k + 3] * ada_w[(size_t)(k + 3) * 6144 + j]; }
                mod[gt] = ada_b[j] + ((a0 + a1) + (a2 + a3)); }
            __syncthreads();
        }
        if (gt < NH * SEQ) { const int d = gt & (SEQ - 1), h = gt >> 11; int bucket = d;
            if (d >= 16) bucket = 16 + (d >= 21) + (d >= 27) + (d >= 35) + (d >= 46) + (d >= 59) + (d >= 77) + (d >= 99) + (d >= 128) + (d >= 166) + (d >= 216) + (d >= 280) + (d >= 363) + (d >= 470) + (d >= 609) + (d >= 790);
            relb[gt] = ap->in[8][bucket * NH + h] * LOG2E; }
        if (gt < NBATCH * 8 * NH * HD) kmean[gt] = 0.f;
        LAS float* scr = (LAS float*)(lds + wave * 16384);
        constexpr int I_IN = 16 * (NPROJ_PAD / 32), I_A = 16 * 32, I_S = 32 * 32, I_O = 16 * 32, I_1 = 16 * 64, I_2 = 16 * 32;
        constexpr int NITEMS = I_IN + I_A + I_S + I_O + NE * I_1 + NE * I_2;
        for (int it = gw; it < NITEMS; it += NGW) {
            int r = it;
            if (r < I_IN) { const int nb = r % (NPROJ_PAD / 32), kb_ = r / (NPROJ_PAD / 32); p0_transpose_item(ap->in[5], D, NPROJ, win_logical(nb * 32), WinT, nb * 32, kb_ * 64, nullptr, scr, lane); continue; } r -= I_IN;
            if (r < I_A) { const int nb = r % 32, kb_ = r / 32; p0_transpose_item(ap->in[15], D, D, nb * 32, WaT, nb * 32, kb_ * 64, nullptr, scr, lane); continue; } r -= I_A;
            if (r < I_S) { const int nb = r % 32, kb_ = r / 32; p0_transpose_item(ap->in[16], SI, D, nb * 32, WsT, nb * 32, kb_ * 64, ap->in[14], scr, lane); continue; } r -= I_S;
            if (r < I_O) { const int nb = r % 32, kb_ = r / 32; p0_transpose_item(ap->in[18], D, D, nb * 32, WoT, nb * 32, kb_ * 64, nullptr, scr, lane); continue; } r -= I_O;
            if (r < NE * I_1) { const int e = r / I_1, q = r % I_1, nb = q % 64, kb_ = q / 64; p0_transpose_item(ap->in[22] + (size_t)e * D * 2048, D, 2048, w1_logical(nb * 32), W1T + (size_t)e * 2048 * D, nb * 32, kb_ * 64, nullptr, scr, lane); continue; } r -= NE * I_1;
            { const int e = r / I_2, q = r % I_2, nb = q % 32, kb_ = q / 32; p0_transpose_item(ap->in[24] + (size_t)e * FF * D, FF, D, nb * 32, W2T + (size_t)e * D * FF, nb * 32, kb_ * 64, nullptr, scr, lane); }
        }
    }
    SEAM(PH_PRO);
    if (IN(PH_NORM1)) {
        PHASE_IDS();
        const float* g1 = ap->in[4];
        for (int row = gw; row < T; row += NGW) {
            const int b = row >> 11; f32x4 v[4]; float s = 0.f;
#pragma unroll
            for (int j = 0; j < 4; ++j) { v[j] = *(const f32x4*)(xin + (size_t)row * D + 4 * lane + 256 * j); s += (v[j].x * v[j].x + v[j].y * v[j].y) + (v[j].z * v[j].z + v[j].w * v[j].w); }
            const float rs = rsqrtf(wave_sum(s) * (1.f / D) + EPS);
            const float* shift = mod + b * 6144, *scale = shift + D;
#pragma unroll
            for (int j = 0; j < 4; ++j) { const int col = 4 * lane + 256 * j; const f32x4 gg = *(const f32x4*)(g1 + col), sc = *(const f32x4*)(scale + col), sh = *(const f32x4*)(shift + col);
                const f32x4 o = v[j] * rs * gg * (sc + 1.f) + sh; u32x2 w; w.x = pg8::cvt_pk_bf16(o[0], o[1]); w.y = pg8::cvt_pk_bf16(o[2], o[3]); *(u32x2*)(ub + (size_t)row * D + col) = w; }
        }
    }
    SEAM(PH_NORM1);
    if (IN(PH_INPROJ)) {
        pg8::Gemm g{nullptr, D, D, D}; pg8::StaticOrder S; S.init(T, NPROJ_PAD, G, bx, ub, D, WinT, D, WGM_INPROJ);
        epi::EpiInProj E{ws, ap->in[6], ap->in[7], kmean};
        pg8::gemm_phase<epi::EpiInProj, pg8::StaticOrder, false>(lds, g, S, E, nullptr);
    }
    SEAM(PH_INPROJ);
    if (IN(PH_MIX1)) {
        bf16* Ccg = (bf16*)(ws + OFF_U); bf16* BcTg = (bf16*)(ws + OFF_U + 32 * MiB); bf16* CBm = (bf16*)(ws + OFF_CB);
        for (int un = bx; un < NBATCH * ssd::NCH * SG; un += G) ssd::pre_unit(un, lds, brw, crw, ap->in[9], ap->in[10], CBm, Ccg, BcTg);
        __syncthreads();
        const int vcu = (G % 8 == 0) ? (bx % 8) * (G / 8) + bx / 8 : bx;
        if (ap->pad != 2) for (int bh = vcu; bh < NBATCH * NH; bh += G) {
            const int b = bh >> 4, h = bh & 15;
            attn_body::fill_tables((char*)lds_raw, relb + h * SEQ); __syncthreads();
            bf16* Op = ap->pad ? (bf16*)(ws + OFF_YB) : cat; asm volatile("" : "+s"(Op));
            for (int qb = 7; qb >= 0; --qb) attn_body::attn_unit<8>(b, h, qb, cat, kb, vb, Op, kmean + ((size_t)b * 8 * NH + h) * 64, (char*)lds_raw);
            __syncthreads();
        }
    }
    SEAM(PH_MIX1);
    if (IN(PH_MIX2)) {
        PHASE_IDS();
        const bf16* Ccg = (const bf16*)(ws + OFF_U); const bf16* BcTg = (const bf16*)(ws + OFF_U + 32 * MiB); const bf16* CBm = (const bf16*)(ws + OFF_CB);
        for (int pr = bx; pr < NBATCH * SH / 2; pr += G)
            ssd::main_pair(2 * pr + (wave >> 2), lds, cat, ap->pad ? (bf16*)(ws + OFF_YB) : cat, ap->pad ? (float*)(ws + OFF_YB) : (float*)(ws + OFF_SSQ), xs, dtraw, CBm, Ccg, BcTg, ap->in[9], ap->in[10], ap->in[11], ap->in[12], ap->in[13]);
    }
    SEAM(PH_MIX2);
    if (IN(PH_MRGA)) {
        pg8::Gemm g{nullptr, CATP, D, D}; pg8::StaticOrder S; S.init(T, D, G, bx, cat, CATP, WaT, D, WGM_MRG);
        epi::EpiMergedA E{ws, ap->in[17]};
        pg8::gemm_phase<epi::EpiMergedA, pg8::StaticOrder, false>(lds, g, S, E, nullptr);
    }
    if (IN(PH_MRGB)) {
        pg8::Gemm g{nullptr, CATP, SI, SI}; pg8::StaticOrder S; S.init(T, D, G, bx, cat + 1024, CATP, WsT, SI, WGM_MRG);
        epi::EpiMergedB E{ws, ap->in[17]};
        pg8::gemm_phase<epi::EpiMergedB, pg8::StaticOrder, false>(lds, g, S, E, nullptr);
    }
    SEAM(PH_MRGB);
    if (IN(PH_OUT)) {
        pg8::Gemm g{nullptr, D, D, D}; pg8::StaticOrder S; S.init(T, D, G, bx, merged, D, WoT, D, WGM_MRG);
        epi::EpiOut E{xin, mod, out};
        pg8::gemm_phase<epi::EpiOut, pg8::StaticOrder, false>(lds, g, S, E, nullptr);
    }
    SEAM(PH_OUT);
    if (IN(PH_ROUTER)) {
        const bool dry = ap->pad == 1;
        for (int rb = bx; rb < T / 128; rb += G) router_block(rb, lds, out, ap->in[19], mod, ap->in[20], ap->in[21], u2, dry ? ctl + 64 : ctl, dry ? (int*)(ws + OFF_YB) : list, dry ? (float*)(ws + OFF_YB + 8 * MiB) : topkw);
    }
    SEAM(PH_ROUTER);
    if (IN(PH_MOE1) || IN(PH_MOE2)) {
        PHASE_IDS();
        if (tid < 64) {
            const int cnt = tid < NE ? (int)__hip_atomic_load(ctl + CW_COUNTS + tid, RLX_AGENT) : 0; const int tiles = (cnt + 255) >> 8; int incl = tiles;
#pragma unroll
            for (int o = 1; o < 32; o <<= 1) { const int t_ = __shfl_up(incl, o); if (lane >= o) incl += t_; }
            if (tid < NE) { LCTL[tid] = incl - tiles; LCTL[64 + tid] = cnt; }
            if (tid == NE - 1) LCTL[NE] = incl;
        }
        __syncthreads();
    }
    if (IN(PH_MOE1)) {
        PHASE_IDS();
        pg8::MoeOrder S; S.init(LCTL, 2048, G, bx, nullptr, D, W1T, D, (size_t)2048 * D * 2, WGM_MOE1);
        LAS unsigned* tab = (LAS unsigned*)(lds + TAB_OFF);
        { pg8::Unit u; for (int i = wave; S.next(i, u); i += NWAVES) {
              const int sb = (u.pm - LCTL[u.e]) * 256 + lane, cnt = LCTL[64 + u.e]; const int* le = list + u.e * LISTCAP; int ent[4];
#pragma unroll
              for (int j = 0; j < 4; ++j) { const int slot = sb + 64 * j; ent[j] = le[slot < cnt ? slot : 0]; }
#pragma unroll
              for (int j = 0; j < 4; ++j) tab[i * 256 + lane + 64 * j] = (unsigned)(ent[j] >> 2) * (unsigned)(D * 2); } }
        __syncthreads();
        pg8::Gemm g{(const char*)u2, D, D, D};
        epi::EpiMoe1 E{ap->in[23], hb};
        pg8::gemm_phase<epi::EpiMoe1, pg8::MoeOrder, true>(lds, g, S, E, tab);
    }
    SEAM(PH_MOE1);
    if (IN(PH_MOE2)) {
        PHASE_IDS();
        pg8::MoeOrder S; S.init(LCTL, D, G, bx, hb, FF, W2T, FF, (size_t)D * FF * 2, WGM_MOE2);
        LAS int* tabE = (LAS int*)(lds + TAB_OFF); LAS float* tabW = (LAS float*)(lds + TAB_OFF + 12288);
        { pg8::Unit u; for (int i = wave; S.next(i, u); i += NWAVES) {
              const int sb = (u.pm - LCTL[u.e]) * 256 + lane, cnt = LCTL[64 + u.e]; const int* le = list + u.e * LISTCAP; int ent[4]; float wv[4];
#pragma unroll
              for (int j = 0; j < 4; ++j) { const int slot = sb + 64 * j; ent[j] = slot < cnt ? le[slot] : -1; }
#pragma unroll
              for (int j = 0; j < 4; ++j) wv[j] = ent[j] >= 0 ? topkw[ent[j]] : 0.f;
#pragma unroll
              for (int j = 0; j < 4; ++j) { tabE[i * 256 + lane + 64 * j] = ent[j]; tabW[i * 256 + lane + 64 * j] = wv[j]; } } }
        __syncthreads();
        pg8::Gemm g{nullptr, FF, FF, FF};
        epi::EpiMoe2 E{ap->in[25], yb, tabE, tabW};
        pg8::gemm_phase<epi::EpiMoe2, pg8::MoeOrder, false>(lds, g, S, E, nullptr);
    }
    SEAM(PH_MOE2);
    if (IN(PH_FINAL)) {
        PHASE_IDS();
        const int gt = bx * (NWAVES * 64) + tid, NT = G * NWAVES * 64;
        for (size_t i8 = gt; i8 < (size_t)T * D / 8; i8 += NT) {
            const size_t idx = i8 * 8; const int t = (int)(idx >> 10), n = (int)(idx & 1023), b = t >> 11;
            f32x4 s0 = {0.f, 0.f, 0.f, 0.f}, s1 = {0.f, 0.f, 0.f, 0.f};
#pragma unroll
            for (int k = 0; k < 4; ++k) { f32x4 a, c; epi::unpack8(*(const u32x4*)(yb + ((size_t)t * 4 + k) * D + n), a, c); s0 += a; s1 += c; }
            const float* g2 = mod + b * 6144 + 5 * D + n;
            float* dst = ap->pad == 1 ? (float*)(ws + OFF_HB) : out;
            *(f32x4*)(dst + idx) = *(const f32x4*)(out + idx) + *(const f32x4*)(g2) * s0; *(f32x4*)(dst + idx + 4) = *(const f32x4*)(out + idx + 4) + *(const f32x4*)(g2 + 4) * s1;
        }
    }
#undef IN
#undef SEAM
#undef PHASE_IDS
#undef ws
#undef ctl
#undef xin
#undef out
#undef mod
#undef relb
#undef kmean
#undef topkw
#undef list
#undef dtraw
#undef WinT
#undef WaT
#undef WsT
#undef WoT
#undef W1T
#undef W2T
#undef ub
#undef cat
#undef kb
#undef vb
#undef xs
#undef brw
#undef crw
#undef gates
#undef u2
#undef hb
#undef yb
#undef merged
}
static void launch_mega(const Args& base, int lo, int hi, int li, hipStream_t stream) {
    Args a = base; a.ph_lo = lo; a.ph_hi = hi; a.li = li;
    hipLaunchKernelGGL(mega, dim3(256), dim3(NWAVES * 64), LDS_BYTES, stream, a);
}
extern "C" void kernel_launch(void* const* d_in, const int* in_sizes, int n_in, void* d_out, int out_size, void* d_ws, size_t ws_size, hipStream_t stream) {
    if (n_in != 26 || ws_size < WS_NEED || out_size != T * D) { fprintf(stderr, "kernel_launch: unexpected sizes (n_in %d ws %zu out %d)\n", n_in, ws_size, out_size); return; }
    static bool attr_set = false;
    if (!attr_set) { (void)hipFuncSetAttribute((const void*)mega, hipFuncAttributeMaxDynamicSharedMemorySize, LDS_BYTES); attr_set = true; }
    const float* conv_w = (const float*)d_in[9]; const float* conv_b = (const float*)d_in[10]; const float* dt_bias = (const float*)d_in[11];
    const float* a_log = (const float*)d_in[12]; const float* d_skip = (const float*)d_in[13]; const float* norm2_g = (const float*)d_in[19];
    const float* router_w = (const float*)d_in[20]; const float* router_b = (const float*)d_in[21];
    char* ws = (char*)d_ws; float* out = (float*)d_out;
    unsigned* ctl = (unsigned*)(ws + OFF_CTL); float* mod = (float*)(ws + OFF_MOD); float* relb = (float*)(ws + OFF_RELB); float* kmean = (float*)(ws + OFF_KMEAN);
    float* topkw = (float*)(ws + OFF_TOPKW); int* list = (int*)(ws + OFF_LIST); float* dtraw = (float*)(ws + OFF_DTRAW);
    bf16* cat = (bf16*)(ws + OFF_CAT); bf16* kb = (bf16*)(ws + OFF_K); bf16* vb = (bf16*)(ws + OFF_V); bf16* xs = (bf16*)(ws + OFF_XS);
    bf16* brw = (bf16*)(ws + OFF_BR); bf16* crw = (bf16*)(ws + OFF_CR); bf16* u2 = (bf16*)(ws + OFF_U2);
    Args a{};
    for (int i = 0; i < 26; ++i) a.in[i] = (const float*)d_in[i];
    a.out = out; a.ws = (unsigned char*)d_ws;
    (void)hipMemsetAsync(ws + OFF_CTL, 0, 1 * MiB, stream);
    launch_mega(a, PH_PRO, PH_COUNT, 0, stream);
}
```

```cpp
#include <hip/hip_runtime.h>
#include <cstdint>
#include <cstdio>

typedef unsigned short bf16;
typedef short bf16x8 __attribute__((ext_vector_type(8)));
typedef float f32x4 __attribute__((ext_vector_type(4)));

constexpr int D = 1024, NBATCH = 16, SEQ = 2048, T = NBATCH * SEQ;
constexpr int NH = 16, HD = 64;
constexpr int SI = 2048, SH = 32, SP = 64, SG = 4, SN = 128, CONVD = 3072;
constexpr int NE = 32, FF = 1024;
constexpr int NPROJ = 10272, NPROJ_PAD = 10496, NPROJ_MAIN = 10240;
constexpr int CATP = 3072;
constexpr int LISTCAP = 32768;
constexpr int MOE_ROWS = 4 * T + NE * 256;
constexpr float EPS = 1e-6f;
constexpr float LOG2E = 1.4426950408889634f;
constexpr float QSCALE = 0.125f * LOG2E;

constexpr size_t MiB = 1u << 20;
constexpr size_t OFF_CTL = 0;
constexpr size_t OFF_MOD = 1 * MiB;
constexpr size_t OFF_RELB = 1 * MiB + 512 * 1024;
constexpr size_t OFF_KMEAN = 2 * MiB;
constexpr size_t OFF_TOPKW = 3 * MiB + 512 * 1024;
constexpr size_t OFF_LIST = 4 * MiB;
constexpr size_t OFF_DTRAW = 8 * MiB;
constexpr size_t OFF_SSQ = 20 * MiB;
constexpr size_t OFF_RST = 16 * MiB;
constexpr size_t OFF_WIN = 24 * MiB;
constexpr size_t OFF_WA = 45 * MiB, OFF_WS = 47 * MiB, OFF_WO = 51 * MiB;
constexpr size_t OFF_W1 = 54 * MiB;
constexpr size_t OFF_W2 = 182 * MiB;
constexpr size_t OFF_U = 246 * MiB;
constexpr size_t OFF_CAT = 310 * MiB;
constexpr size_t OFF_K = 502 * MiB;
constexpr size_t OFF_V = 566 * MiB;
constexpr size_t OFF_XS = 630 * MiB;
constexpr size_t OFF_BR = 758 * MiB, OFF_CR = 790 * MiB;
constexpr size_t OFF_GATES = 822 * MiB;
constexpr size_t OFF_CB = 950 * MiB;
constexpr size_t OFF_Y1 = 838 * MiB;
constexpr size_t OFF_U2 = 246 * MiB;
constexpr size_t OFF_HB = 310 * MiB;
constexpr size_t OFF_YB = 582 * MiB;
constexpr size_t WS_NEED = 982 * MiB;
constexpr int CW_COUNTS = 1024;
constexpr int CW_QHEAD = 2048;
constexpr int CW_TILEBASE = 1088;

__device__ __forceinline__ float bf2f(bf16 v) { return __uint_as_float(((unsigned)v) << 16); }
__device__ __forceinline__ bf16 f2bf(float f) { unsigned u = __float_as_uint(f); return (bf16)((u + 0x7fffu + ((u >> 16) & 1u)) >> 16); }
__device__ __forceinline__ float siluf(float x) { return x / (1.f + __expf(-x)); }
__device__ __forceinline__ float sigm(float x) { return 1.f / (1.f + __expf(-x)); }
__device__ __forceinline__ float wave_sum(float v) {
#pragma unroll
    for (int o = 1; o < 64; o <<= 1) v += __shfl_xor(v, o);
    return v;
}
__device__ __forceinline__ float wave_max(float v) {
#pragma unroll
    for (int o = 1; o < 64; o <<= 1) v = fmaxf(v, __shfl_xor(v, o));
    return v;
}
__device__ __forceinline__ float softplusf(float x) { return x > 20.f ? x : log1pf(__expf(x)); }
__device__ __forceinline__ float silu_fast(float x) { return x * __builtin_amdgcn_rcpf(1.f + __builtin_amdgcn_exp2f(-LOG2E * x)); }
__device__ __forceinline__ float softplus_fast(float x) { const float t = __builtin_amdgcn_exp2f(LOG2E * x); return x > 20.f ? x : (t < 1e-3f ? t * (1.f - 0.5f * t) : 0.6931471805599453f * __builtin_amdgcn_logf(1.f + t)); }

__host__ __device__ __forceinline__ int win_logical(int n) {
    if (n >= NPROJ) return -1;
    const int tile = n >> 8;
    if (tile < 8) { const int l = n & 255, bj = (l >> 7) & 1, wc = (l >> 5) & 3, j = l & 31; return tile * 256 + 64 * wc + 32 * bj + j; }
    if (n < 8192) return n;
    if (n < 10240) return n + 32;
    return n - 2048;
}
__host__ __device__ __forceinline__ int w1_logical(int n) { const int pn = n >> 8, bj = (n >> 7) & 1, j = n & 127; return bj * 1024 + pn * 128 + j; }

constexpr int NWAVES = 8;
constexpr int RING_BYTES = 131072, TAB_OFF = RING_BYTES, TAB_BYTES = 24576, LCTL_OFF = TAB_OFF + TAB_BYTES, LDS_BYTES = 163840;
__device__ __forceinline__ int hw_wave_slot() { return (int)__builtin_amdgcn_s_getreg((5 << 11) | 4) & 63; }
__device__ __forceinline__ int lane_id() { return (int)__builtin_amdgcn_mbcnt_hi(~0u, __builtin_amdgcn_mbcnt_lo(~0u, 0u)); }
__device__ __forceinline__ int wave_idx() { extern __shared__ __attribute__((aligned(16))) unsigned char lds_raw_[]; return __builtin_amdgcn_readfirstlane(((volatile __attribute__((address_space(3))) int*)((__attribute__((address_space(3))) unsigned char*)lds_raw_ + LCTL_OFF))[192 + hw_wave_slot()]); }
__device__ __forceinline__ int tidx() { return wave_idx() * 64 + lane_id(); }

#define LAS __attribute__((address_space(3)))
#define GAS __attribute__((address_space(1)))
typedef unsigned u32x4 __attribute__((ext_vector_type(4)));
typedef unsigned u32x2 __attribute__((ext_vector_type(2)));
namespace pg8 {
constexpr int BM = 256, BK = 64, HALF = 128, HTB = HALF * BK * 2, STAGE_BYTES = 8 * HTB, NXCD = 8;
__host__ __device__ __forceinline__ int lds_byte(int r, int c) { const int st = (r >> 4) * 2 + (c >> 5), rr = r & 15, cc = c & 31, ob = rr * 64 + cc * 2; return st * 1024 + (ob ^ (((ob >> 9) & 1) << 5)); }
__host__ __device__ __forceinline__ void stage_rc(int b, int& R, int& C) { const int st = b / 1024, sb = b % 1024, swz = sb ^ (((sb >> 9) & 1) << 5); R = (st >> 1) * 16 + swz / 64; C = (st & 1) * 32 + (swz % 64) / 2; }
__host__ __device__ __forceinline__ int perm32(int rho) { const int n = rho >> 4, i = rho & 15; return 8 * (i >> 2) + 4 * n + (i & 3); }

struct Unit { int pm, pn, e; const char* a; const char* b; };
struct Gemm { const char* A; int lda, ldb, K; };

__device__ __forceinline__ void order_map(int L, int nM, int nN, int WGM, int& pm, int& pn) {
    const int nwg = nM * nN; int wgid = L;
    { const int q = nwg / NXCD, r = nwg % NXCD, xcd = wgid % NXCD, off = wgid / NXCD; wgid = (xcd < r ? xcd * (q + 1) : r * (q + 1) + (xcd - r) * q) + off; }
    const int nig = WGM * nN, gid = wgid / nig, fm = gid * WGM, gsz = (nM - fm) < WGM ? (nM - fm) : WGM;
    pm = fm + ((wgid % nig) % gsz); pn = (wgid % nig) / gsz;
}
struct StaticOrder {
    int nM, nN, nwg, G, c, wgm; const char* A; const char* B; size_t atile, btile;
    __device__ __forceinline__ void init(int M, int N, int G_, int c_, const void* A_, int lda, const void* B_, int ldb, int wgm_) { wgm = wgm_; nM = M / BM; nN = N / BM; nwg = nM * nN; G = G_; c = c_; A = (const char*)A_; B = (const char*)B_; atile = (size_t)BM * lda * 2; btile = (size_t)BM * ldb * 2; }
    __device__ __forceinline__ bool next(int i, Unit& u) const {
        const long L = (long)i * G + c; if (L >= nwg) return false;
        order_map((int)L, nM, nN, wgm, u.pm, u.pn); u.e = 0; u.a = A + (size_t)u.pm * atile; u.b = B + (size_t)u.pn * btile; return true;
    }
};
struct MoeOrder {
    int nM, nN, nwg, G, c, wgm; const volatile LAS int* tb; const char* A; const char* B; size_t atile, btile, estride;
    __device__ __forceinline__ void init(const volatile LAS int* tb_, int N, int G_, int c_, const void* A_, int lda, const void* B_, int ldb, size_t estride_, int wgm_) { wgm = wgm_;
        tb = tb_; nM = tb_[NE]; nN = N / BM; nwg = nM * nN; G = G_; c = c_; A = (const char*)A_; B = (const char*)B_; atile = (size_t)BM * lda * 2; btile = (size_t)BM * ldb * 2; estride = estride_; }
    __device__ __forceinline__ bool next(int i, Unit& u) const {
        const long L = (long)i * G + c; if (L >= nwg) return false;
        order_map((int)L, nM, nN, wgm, u.pm, u.pn);
        const int ln_ = lane_id(); const int tv_ = (ln_ >= 1 && ln_ < NE) ? tb[ln_] : 0x7fffffff;
        const int e = __popcll(__ballot(tv_ <= u.pm));
        u.e = __builtin_amdgcn_readfirstlane(e); u.a = A + (size_t)u.pm * atile; u.b = B + (size_t)u.e * estride + (size_t)u.pn * btile; return true;
    }
};

__device__ __forceinline__ unsigned cvt_pk_bf16(float lo, float hi) { unsigned r; asm volatile("v_cvt_pk_bf16_f32 %0, %1, %2" : "=v"(r) : "v"(lo), "v"(hi)); return r; }

template <class Epi, class Sched, bool GATHER, bool NARROW = false>
__device__ __forceinline__ void gemm_phase(LAS unsigned char* lds, const Gemm g, const Sched& S, const Epi& E, const LAS unsigned* tab) {
    const int tid = tidx(), wid = __builtin_amdgcn_readfirstlane(tid >> 6), lane = tid & 63, wr = wid >> 2, wc = wid & 3, fr = lane & 15, fq = lane >> 4;
    const int K = g.K, nt = K / BK;
    unsigned voffA[2], voffB[2]; int R0, C0;
    { int R, C; stage_rc(tid * 16, R, C); R0 = R; C0 = C; }
#pragma unroll
    for (int i = 0; i < 2; ++i) { int R, C; stage_rc(tid * 16 + i * 8192, R, C); const int Rb = (R & ~31) + perm32(R & 31);
        voffA[i] = (unsigned)(R * g.lda + C) * 2u; voffB[i] = (unsigned)(Rb * g.ldb + C) * 2u; }
    const size_t kstep = (size_t)(BK * 2);
    const size_t hstepA = (size_t)HALF * g.lda * 2, hstepB = (size_t)HALF * g.ldb * 2;
    const unsigned ldsw = (unsigned)wid * 1024u;
    const int aoff = lds_byte(wr * 64 + fr, fq * 8), boff = lds_byte(wc * 32 + fr, fq * 8);
#define PG8_SA(b, h) (((b) * 2 + (h)) * HTB)
#define PG8_SB(b, h) ((4 + (b) * 2 + (h)) * HTB)
#define PG8_STAGE(bufoff, gbase, voff) do { _Pragma("unroll") for (int _i = 0; _i < 2; ++_i) \
        __builtin_amdgcn_global_load_lds((const unsigned*)((const char*)(gbase) + (voff)[_i]), (LAS unsigned*)(lds + (bufoff) + ldsw + _i * 8192), 16, 0, 0); } while (0)
#define PG8_STA(bufoff, kb, h, nx) do { if constexpr (GATHER) { unsigned _v[2]; _v[0] = (nx) ? gn[h][0] : gc[h][0]; _v[1] = (nx) ? gn[h][1] : gc[h][1]; PG8_STAGE(bufoff, g.A + (kb), _v); } \
        else { PG8_STAGE(bufoff, ((nx) ? nA : cA) + (kb) + (h) * hstepA, voffA); } } while (0)
#define PG8_LDA(dst, b, h) do { _Pragma("unroll") for (int m = 0; m < 4; ++m) _Pragma("unroll") for (int k = 0; k < 2; ++k) dst[m][k] = *(const LAS bf16x8*)(lds + PG8_SA(b, h) + aoff + m * 2048 + k * 1024); } while (0)
#define PG8_LDB(dst, b, h) do { _Pragma("unroll") for (int n = 0; n < 2; ++n) _Pragma("unroll") for (int k = 0; k < 2; ++k) dst[n][k] = *(const LAS bf16x8*)(lds + PG8_SB(b, h) + boff + n * 2048 + k * 1024); } while (0)
#define PG8_MMA(ai, bj, At, Bt) do { if (NARROW && ((bj) != 0 || wc != 0)) break; __builtin_amdgcn_s_setprio(1); _Pragma("unroll") for (int m = 0; m < 4; ++m) _Pragma("unroll") for (int n = 0; n < 2; ++n) _Pragma("unroll") for (int k = 0; k < 2; ++k) \
        acc[ai][bj][m][n] = __builtin_amdgcn_mfma_f32_16x16x32_bf16(Bt[n][k], At[m][k], acc[ai][bj][m][n], 0, 0, 0); __builtin_amdgcn_s_setprio(0); } while (0)
#define PG8_WAIT_V(n) asm volatile("s_waitcnt vmcnt(" #n ")" ::: "memory")
#define PG8_WAIT_L(n) asm volatile("s_waitcnt lgkmcnt(" #n ")" ::: "memory")
#define PG8_BAR __builtin_amdgcn_s_barrier()
#define PG8_SCHED __builtin_amdgcn_sched_barrier(0)
#define PG8_GOFF(dst, uidx) do { _Pragma("unroll") for (int h = 0; h < 2; ++h) _Pragma("unroll") for (int i = 0; i < 2; ++i) dst[h][i] = tab[(uidx) * 256 + h * 128 + i * 64 + R0] + (unsigned)(C0 * 2); } while (0)
    Unit cur, nxt; int ui = 0;
    if (!S.next(0, cur)) return;
    f32x4 acc[2][2][4][2];
#pragma unroll
    for (int a = 0; a < 2; ++a)
#pragma unroll
        for (int b = 0; b < 2; ++b)
#pragma unroll
            for (int m = 0; m < 4; ++m)
#pragma unroll
                for (int n = 0; n < 2; ++n) acc[a][b][m][n] = (f32x4){0.f, 0.f, 0.f, 0.f};
    bf16x8 At[4][2], B0[2][2], B1[2][2];
    const char* cA = cur.a; const char* cB = cur.b; const char* nA = cA;
    unsigned gc[2][2] = {{0u, 0u}, {0u, 0u}}, gn[2][2] = {{0u, 0u}, {0u, 0u}};
    if constexpr (GATHER) { PG8_GOFF(gc, 0); }
    PG8_STAGE(PG8_SB(0, 0), cB, voffB); PG8_STAGE(PG8_SB(0, 1), cB + hstepB, voffB); PG8_STA(PG8_SA(0, 0), 0, 0, false); PG8_STA(PG8_SA(0, 1), 0, 1, false);
    if (wr == 1) PG8_BAR;
    PG8_WAIT_V(2); PG8_BAR;
    PG8_STAGE(PG8_SB(1, 0), cB + kstep, voffB); PG8_STA(PG8_SA(1, 0), kstep, 0, false); PG8_STAGE(PG8_SB(1, 1), cB + hstepB + kstep, voffB);
    PG8_WAIT_V(6); PG8_BAR;
    for (;;) {
        const bool has_next = S.next(ui + 1, nxt);
        nA = has_next ? nxt.a : cA; const char* nB = has_next ? nxt.b : cB;
        if constexpr (GATHER) { if (has_next) { PG8_GOFF(gn, ui + 1); } else {
#pragma unroll
            for (int h = 0; h < 2; ++h) { gn[h][0] = gc[h][0]; gn[h][1] = gc[h][1]; } } }
        for (int t = 0; t < nt; t += 2) {
            if constexpr (Epi::HOOKS) { if (t == 8 || t == 16 || t == 24) E.hook(acc, cur, ui, t, wr, fr); }
            const bool last = (t == nt - 2);
            const size_t k1 = (size_t)(t + 1) * kstep, k2 = last ? 0 : (size_t)(t + 2) * kstep, k3 = k2 + kstep;
            const char* b2 = last ? nB : cB + (size_t)(t + 2) * kstep; const char* b3 = b2 + kstep;
            PG8_LDB(B0, 0, 0); PG8_LDB(B1, 0, 1); PG8_SCHED; PG8_LDA(At, 0, 0); PG8_STA(PG8_SA(1, 1), k1, 1, false);
            PG8_WAIT_V(8); PG8_WAIT_L(0); PG8_BAR; PG8_MMA(0, 0, At, B0); PG8_MMA(0, 1, At, B1); PG8_BAR; PG8_SCHED;
            PG8_LDA(At, 0, 1); PG8_STAGE(PG8_SB(0, 0), b2, voffB); PG8_STAGE(PG8_SB(0, 1), b2 + hstepB, voffB); PG8_STA(PG8_SA(0, 0), k2, 0, last);
            PG8_WAIT_V(8); PG8_WAIT_L(0); PG8_BAR; PG8_MMA(1, 0, At, B0); PG8_MMA(1, 1, At, B1); PG8_BAR; PG8_SCHED;
            PG8_LDB(B0, 1, 0); PG8_LDB(B1, 1, 1); PG8_SCHED; PG8_LDA(At, 1, 0); PG8_STA(PG8_SA(0, 1), k2, 1, last);
            PG8_WAIT_V(8); PG8_WAIT_L(0); PG8_BAR; PG8_MMA(0, 0, At, B0); PG8_MMA(0, 1, At, B1); PG8_BAR; PG8_SCHED;
            PG8_LDA(At, 1, 1); PG8_STAGE(PG8_SB(1, 0), b3, voffB); PG8_STAGE(PG8_SB(1, 1), b3 + hstepB, voffB); PG8_STA(PG8_SA(1, 0), k3, 0, last);
            PG8_WAIT_V(8); PG8_WAIT_L(0); PG8_BAR; PG8_MMA(1, 0, At, B0); PG8_MMA(1, 1, At, B1); PG8_BAR; PG8_SCHED;
        }
        if (wr == 0) PG8_BAR;
        E(acc, cur, ui, wr, wc, fr, fq);
        if (!has_next) break;
#pragma unroll
        for (int a = 0; a < 2; ++a)
#pragma unroll
            for (int b = 0; b < 2; ++b)
#pragma unroll
                for (int m = 0; m < 4; ++m)
#pragma unroll
                    for (int n = 0; n < 2; ++n) acc[a][b][m][n] = (f32x4){0.f, 0.f, 0.f, 0.f};
        cur = nxt; cA = nA; cB = nB; ++ui;
        if constexpr (GATHER) {
#pragma unroll
            for (int h = 0; h < 2; ++h) { gc[h][0] = gn[h][0]; gc[h][1] = gn[h][1]; } }
        if (wr == 1) PG8_BAR;
    }
    PG8_WAIT_V(0);
    PG8_BAR;
#undef PG8_SA
#undef PG8_SB
#undef PG8_STAGE
#undef PG8_STA
#undef PG8_LDA
#undef PG8_LDB
#undef PG8_MMA
#undef PG8_WAIT_V
#undef PG8_WAIT_L
#undef PG8_BAR
#undef PG8_SCHED
#undef PG8_GOFF
}
}
namespace epi {
using pg8::Unit; using pg8::cvt_pk_bf16;
__device__ __forceinline__ u32x4 pack8(const f32x4& a, const f32x4& b) { u32x4 w; w.x = cvt_pk_bf16(a[0], a[1]); w.y = cvt_pk_bf16(a[2], a[3]); w.z = cvt_pk_bf16(b[0], b[1]); w.w = cvt_pk_bf16(b[2], b[3]); return w; }
__device__ __forceinline__ void unpack8(const u32x4& w, f32x4& a, f32x4& b) {
    a[0] = __uint_as_float(w.x << 16); a[1] = __uint_as_float(w.x & 0xffff0000u); a[2] = __uint_as_float(w.y << 16); a[3] = __uint_as_float(w.y & 0xffff0000u);
    b[0] = __uint_as_float(w.z << 16); b[1] = __uint_as_float(w.z & 0xffff0000u); b[2] = __uint_as_float(w.w << 16); b[3] = __uint_as_float(w.w & 0xffff0000u); }
typedef float f32x2_t __attribute__((ext_vector_type(2)));
__device__ __forceinline__ f32x4 sigm4(const f32x4& x) { f32x4 r; r[0] = sigm(x[0]); r[1] = sigm(x[1]); r[2] = sigm(x[2]); r[3] = sigm(x[3]); return r; }

struct EpiInProj { static constexpr bool HOOKS = false;
    unsigned char* wsb; const float *qg, *kg; float* kmean;
    __device__ __forceinline__ void operator()(const f32x4 (&acc)[2][2][4][2], const Unit& u, int ui, int wr, int wc, int fr, int fq) const {
        bf16* cat = (bf16*)(wsb + OFF_CAT); bf16* kb = (bf16*)(wsb + OFF_K); bf16* vb = (bf16*)(wsb + OFF_V); bf16* xs = (bf16*)(wsb + OFF_XS); bf16* brw = (bf16*)(wsb + OFF_BR); bf16* crw = (bf16*)(wsb + OFF_CR);
        bf16* gates = (bf16*)(wsb + OFF_GATES);
        const int pn = u.pn; const int row0 = u.pm * 256 + wr * 64 + fr;
        if (pn < 8) {
            const bool isq = pn < 4; const float* g = isq ? qg : kg; const float sc = isq ? QSCALE : 1.f;
            f32x4 gv[2][2], ks[2][2];
#pragma unroll
            for (int bj = 0; bj < 2; ++bj)
#pragma unroll
                for (int n = 0; n < 2; ++n) { gv[bj][n] = *(const f32x4*)(g + 32 * bj + 8 * fq + 4 * n) * sc; ks[bj][n] = (f32x4){0.f, 0.f, 0.f, 0.f}; }
            bf16* base = isq ? cat + (pn * 256 + 64 * wc + 8 * fq) : kb + ((pn - 4) * 256 + 64 * wc + 8 * fq); const size_t pitch = isq ? CATP : D;
#pragma unroll
            for (int ai = 0; ai < 2; ++ai)
#pragma unroll
                for (int m = 0; m < 4; ++m) {
                    float s = 0.f;
#pragma unroll
                    for (int bj = 0; bj < 2; ++bj)
#pragma unroll
                        for (int n = 0; n < 2; ++n) { const f32x4 x = acc[ai][bj][m][n]; s += (x[0] * x[0] + x[1] * x[1]) + (x[2] * x[2] + x[3] * x[3]); }
                    s += __shfl_xor(s, 16); s += __shfl_xor(s, 32);
                    const float rs = rsqrtf(s * (1.f / 64.f) + EPS);
                    bf16* rowp = isq ? base + (size_t)(row0 + ai * 128 + m * 16) * pitch
                                     : kb + ((size_t)((((u.pm >> 3) * 16 + (pn - 4) * 4 + wc) * 32 + ((u.pm * 4 + wr + 2 * ai) & 31)) * 4096 + fq * 512 + (fr + 16 * m) * 8));
                    const int bjs = isq ? 32 : 2048;
#pragma unroll
                    for (int bj = 0; bj < 2; ++bj) { const f32x4 o0 = acc[ai][bj][m][0] * rs * gv[bj][0], o1 = acc[ai][bj][m][1] * rs * gv[bj][1];
                        *(u32x4*)(rowp + bjs * bj) = pack8(o0, o1); ks[bj][0] += o0; ks[bj][1] += o1; }
                }
            if (!isq) {
                float* km = kmean + ((size_t)u.pm * NH + (pn - 4) * 4 + wc) * 64 + 8 * fq;
#pragma unroll
                for (int bj = 0; bj < 2; ++bj)
#pragma unroll
                    for (int n = 0; n < 2; ++n)
#pragma unroll
                        for (int e = 0; e < 4; ++e) { float v = ks[bj][n][e]; v += __shfl_xor(v, 1); v += __shfl_xor(v, 2); v += __shfl_xor(v, 4); v += __shfl_xor(v, 8);
                            if (fr == 0) atomicAdd(km + 32 * bj + 4 * n + e, v * (1.f / 256.f)); }
            }
        } else if (pn < 12) {
#pragma unroll
            for (int ai = 0; ai < 2; ++ai)
#pragma unroll
                for (int m = 0; m < 4; ++m)
#pragma unroll
                    for (int bj = 0; bj < 2; ++bj) {
                        bf16* p = vb + ((size_t)((((u.pm >> 3) * 16 + (pn - 8) * 4 + 2 * bj + (wc >> 1)) * 32 + ((u.pm * 4 + wr + 2 * ai) & 31)) * 4096 + ((wc & 1) * 4 + m) * 512 + fr * 32 + 8 * fq));
                        __builtin_nontemporal_store(pack8(acc[ai][bj][m][0], acc[ai][bj][m][1]), (u32x4*)p); }
        } else if (pn < 40) {
            bf16* base; size_t pitch;
            if (pn < 20) { base = cat + 1024 + (pn - 12) * 256; pitch = CATP; }
            else if (pn < 28) { base = xs + (pn - 20) * 256; pitch = SI; }
            else if (pn < 30) { base = brw + (pn - 28) * 256; pitch = 512; }
            else if (pn < 32) { base = crw + (pn - 30) * 256; pitch = 512; }
            else { base = gates + (pn - 32) * 256; pitch = 2048; }
            base += wc * 32 + 8 * fq;
#pragma unroll
            for (int ai = 0; ai < 2; ++ai)
#pragma unroll
                for (int m = 0; m < 4; ++m) { bf16* rowp = base + (size_t)(row0 + ai * 128 + m * 16) * pitch;
#pragma unroll
                    for (int bj = 0; bj < 2; ++bj) __builtin_nontemporal_store(pack8(acc[ai][bj][m][0], acc[ai][bj][m][1]), (u32x4*)(rowp + bj * 128)); }
        }
    }
};
struct EpiDt { static constexpr bool HOOKS = false;
    unsigned char* wsb;
    __device__ __forceinline__ void operator()(const f32x4 (&acc)[2][2][4][2], const Unit& u, int ui, int wr, int wc, int fr, int fq) const {
        float* dtraw = (float*)(wsb + OFF_DTRAW); const int row0 = u.pm * 256 + wr * 64 + fr;
        if (wc == 0) {
#pragma unroll
            for (int ai = 0; ai < 2; ++ai)
#pragma unroll
                for (int m = 0; m < 4; ++m) { float* p = dtraw + (size_t)(row0 + ai * 128 + m * 16) * 32 + 8 * fq; *(f32x4*)p = acc[ai][0][m][0]; *(f32x4*)(p + 4) = acc[ai][0][m][1]; }
        }
    }
};
struct EpiMergedA { static constexpr bool HOOKS = false;
    unsigned char* wsb; const float* gb; LAS float* tabR;
    __device__ __forceinline__ void operator()(const f32x4 (&acc)[2][2][4][2], const Unit& u, int ui, int wr, int wc, int fr, int fq) const {
        const bf16* gates = (const bf16*)(wsb + OFF_GATES); bf16* out = (bf16*)(wsb + OFF_K); const float* ssq = (const float*)(wsb + OFF_SSQ);
        const int row0 = u.pm * 256 + wr * 64 + fr, col0 = u.pn * 256 + wc * 32 + 8 * fq;
        f32x2_t rso; { const int tid = tidx(); const size_t r = (size_t)u.pm * 256 + (tid & 255); const int g2 = (tid >> 8) * 2; const float* sp = ssq + r * 32 + 8 * g2;
          const f32x4 a = *(const f32x4*)(sp), b = *(const f32x4*)(sp + 4), c = *(const f32x4*)(sp + 8), d = *(const f32x4*)(sp + 12);
          rso.x = rsqrtf(((a[0] + a[1]) + (a[2] + a[3]) + (b[0] + b[1]) + (b[2] + b[3])) * (1.f / 512.f) + EPS); rso.y = rsqrtf(((c[0] + c[1]) + (c[2] + c[3]) + (d[0] + d[1]) + (d[2] + d[3])) * (1.f / 512.f) + EPS); }
        f32x4 bv[2][2];
#pragma unroll
        for (int bj = 0; bj < 2; ++bj) { bv[bj][0] = *(const f32x4*)(gb + col0 + bj * 128); bv[bj][1] = *(const f32x4*)(gb + col0 + bj * 128 + 4); }
#pragma unroll
        for (int ai = 0; ai < 2; ++ai) {
            u32x4 gq[4][2];
#pragma unroll
            for (int m = 0; m < 4; ++m)
#pragma unroll
                for (int bj = 0; bj < 2; ++bj) gq[m][bj] = *(const u32x4*)(gates + (size_t)(row0 + ai * 128 + m * 16) * 2048 + col0 + bj * 128);
#pragma unroll
            for (int m = 0; m < 4; ++m)
#pragma unroll
                for (int bj = 0; bj < 2; ++bj) { f32x4 g0, g1; unpack8(gq[m][bj], g0, g1);
                    *(u32x4*)(out + (size_t)(row0 + ai * 128 + m * 16) * D + col0 + bj * 128) = pack8(sigm4(g0 + bv[bj][0]) * acc[ai][bj][m][0], sigm4(g1 + bv[bj][1]) * acc[ai][bj][m][1]); }
        }
        { const int tid = tidx(); const int g2 = (tid >> 8) * 2; *(LAS f32x2_t*)(tabR + (ui * 256 + (tid & 255)) * 4 + g2) = rso; }
    }
};
struct EpiMergedB {
    static constexpr bool HOOKS = true;
    unsigned char* wsb; const float* gb; const LAS float* tabR;
    __device__ __forceinline__ void hook(f32x4 (&acc)[2][2][4][2], const Unit& u, int ui, int t, int wr, int fr) const {
        const int g = (t >> 3) - 1;
#pragma unroll
        for (int ai = 0; ai < 2; ++ai)
#pragma unroll
            for (int m = 0; m < 4; ++m) { const f32x4 rs = *(const LAS f32x4*)(tabR + (ui * 256 + wr * 64 + fr + ai * 128 + m * 16) * 4);
                const float f = g == 0 ? rs[0] / rs[1] : (g == 1 ? rs[1] / rs[2] : rs[2] / rs[3]);
#pragma unroll
                for (int bj = 0; bj < 2; ++bj) { acc[ai][bj][m][0] *= f; acc[ai][bj][m][1] *= f; }
                if (m & 1) asm volatile("" ::: "memory"); }
    }
    __device__ __forceinline__ void operator()(const f32x4 (&acc)[2][2][4][2], const Unit& u, int ui, int wr, int wc, int fr, int fq) const {
        const bf16* gates = (const bf16*)(wsb + OFF_GATES); bf16* out = (bf16*)(wsb + OFF_K);
        const int row0 = u.pm * 256 + wr * 64 + fr, col0 = u.pn * 256 + wc * 32 + 8 * fq;
        f32x4 bv[2][2];
#pragma unroll
        for (int bj = 0; bj < 2; ++bj) { bv[bj][0] = *(const f32x4*)(gb + 1024 + col0 + bj * 128); bv[bj][1] = *(const f32x4*)(gb + 1024 + col0 + bj * 128 + 4); }
#pragma unroll
        for (int ai = 0; ai < 2; ++ai)
#pragma unroll
          for (int mh = 0; mh < 4; mh += 2) {
            u32x4 gq[2][2], tq[2][2]; float r3[2];
#pragma unroll
            for (int m = 0; m < 2; ++m) { const size_t r = (size_t)(row0 + ai * 128 + (mh + m) * 16); r3[m] = tabR[(ui * 256 + wr * 64 + fr + ai * 128 + (mh + m) * 16) * 4 + 3];
#pragma unroll
                for (int bj = 0; bj < 2; ++bj) { gq[m][bj] = *(const u32x4*)(gates + r * 2048 + 1024 + col0 + bj * 128); tq[m][bj] = *(const u32x4*)(out + r * D + col0 + bj * 128); } }
#pragma unroll
            for (int m = 0; m < 2; ++m) { const size_t r = (size_t)(row0 + ai * 128 + (mh + m) * 16);
#pragma unroll
                for (int bj = 0; bj < 2; ++bj) { f32x4 g0, g1, t0, t1; unpack8(gq[m][bj], g0, g1); unpack8(tq[m][bj], t0, t1);
                    *(u32x4*)(out + r * D + col0 + bj * 128) = pack8(t0 + sigm4(g0 + bv[bj][0]) * r3[m] * acc[ai][bj][mh + m][0], t1 + sigm4(g1 + bv[bj][1]) * r3[m] * acc[ai][bj][mh + m][1]); } }
            asm volatile("" ::: "memory");
          }
    }
};
struct EpiOut { static constexpr bool HOOKS = false;
    const float* mod; bf16* y1;
    __device__ __forceinline__ void operator()(const f32x4 (&acc)[2][2][4][2], const Unit& u, int ui, int wr, int wc, int fr, int fq) const {
        const int row0 = u.pm * 256 + wr * 64 + fr, col0 = u.pn * 256 + wc * 32 + 8 * fq; const float* g1 = mod + (u.pm >> 3) * 6144 + 2 * D;
        f32x4 gv[2][2];
#pragma unroll
        for (int bj = 0; bj < 2; ++bj) { gv[bj][0] = *(const f32x4*)(g1 + col0 + bj * 128); gv[bj][1] = *(const f32x4*)(g1 + col0 + bj * 128 + 4); }
#pragma unroll
        for (int ai = 0; ai < 2; ++ai)
#pragma unroll
            for (int m = 0; m < 4; ++m)
#pragma unroll
                for (int bj = 0; bj < 2; ++bj) *(u32x4*)(y1 + (size_t)(row0 + ai * 128 + m * 16) * D + col0 + bj * 128) = pack8(gv[bj][0] * acc[ai][bj][m][0], gv[bj][1] * acc[ai][bj][m][1]);
    }
};
__device__ __forceinline__ f32x4 swiglu4(f32x4 g, f32x4 l) { f32x4 r;
#pragma unroll
    for (int i = 0; i < 4; ++i) { const float gg = fminf(g[i], 7.f), ll = fminf(fmaxf(l[i], -7.f), 7.f); r[i] = gg * sigm(1.702f * gg) * (ll + 1.f); } return r; }
struct EpiMoe1 { static constexpr bool HOOKS = false;
    const float* b1; bf16* hb;
    __device__ __forceinline__ void operator()(const f32x4 (&acc)[2][2][4][2], const Unit& u, int ui, int wr, int wc, int fr, int fq) const {
        const int j0 = u.pn * 128 + wc * 32 + 8 * fq; const float* bb = b1 + u.e * 2048 + j0;
        const f32x4 bg0 = *(const f32x4*)(bb), bg1 = *(const f32x4*)(bb + 4), bl0 = *(const f32x4*)(bb + 1024), bl1 = *(const f32x4*)(bb + 1028);
#pragma unroll
        for (int ai = 0; ai < 2; ++ai)
#pragma unroll
            for (int m = 0; m < 4; ++m) { const size_t r = (size_t)u.pm * 256 + ai * 128 + wr * 64 + m * 16 + fr;
                *(u32x4*)(hb + r * FF + j0) = pack8(swiglu4(acc[ai][0][m][0] + bg0, acc[ai][1][m][0] + bl0), swiglu4(acc[ai][0][m][1] + bg1, acc[ai][1][m][1] + bl1)); }
    }
};
struct EpiMoe2 { static constexpr bool HOOKS = false;
    const float* b2; bf16* yb; const LAS int* tabE; const LAS float* tabW;
    __device__ __forceinline__ void operator()(const f32x4 (&acc)[2][2][4][2], const Unit& u, int ui, int wr, int wc, int fr, int fq) const {
        const int col0 = u.pn * 256 + wc * 32 + 8 * fq; const float* bb = b2 + u.e * D + col0;
        f32x4 bv[2][2];
#pragma unroll
        for (int bj = 0; bj < 2; ++bj) { bv[bj][0] = *(const f32x4*)(bb + bj * 128); bv[bj][1] = *(const f32x4*)(bb + bj * 128 + 4); }
#pragma unroll
        for (int ai = 0; ai < 2; ++ai)
#pragma unroll
            for (int m = 0; m < 4; ++m) { const int r = ui * 256 + ai * 128 + wr * 64 + m * 16 + fr; const int ent = tabE[r]; const float w = tabW[r];
                if (ent >= 0) { bf16* p = yb + (size_t)ent * D + col0;
#pragma unroll
                    for (int bj = 0; bj < 2; ++bj) *(u32x4*)(p + bj * 128) = pack8((acc[ai][bj][m][0] + bv[bj][0]) * w, (acc[ai][bj][m][1] + bv[bj][1]) * w); } }
    }
};
}

namespace attn_body {
using bf16=unsigned short;
using bf16x8=__attribute__((ext_vector_type(8)))short;
using s16x4=__attribute__((ext_vector_type(4)))short;
using f32x16=__attribute__((ext_vector_type(16)))float;
constexpr int BATCH=16,NHEAD=16,SEQ=2048,D=64,DM=NHEAD*D,QP=3072;
constexpr int NW=8,QBLK=32,QB=QBLK*NW,KVBLK=64,NQB=SEQ/QB;
constexpr int ATTN_UNIT_ROWS=QB;
constexpr int YOFF=2063, TARR=2384, TARRB=TARR*4, TBL_BYTES=4*TARRB+256;
__device__ __forceinline__ int crow(int r,int hi){return (r&3)+8*(r>>2)+4*hi;}
#define SBAR() __builtin_amdgcn_sched_barrier(0)
__device__ __forceinline__ void cmask(f32x16&p0,f32x16&p1,int jb,int qrel,int hi){
  const float NEG=-INFINITY; const int lim=qrel-4*hi-64*jb;
  #pragma unroll
  for(int r=0;r<16;++r){const int c=(r&3)+8*(r>>2); if(c>lim)p0[r]=NEG; if(c+32>lim)p1[r]=NEG;}
}

constexpr int NSLOT=3, SLOTB=8192;
constexpr int LDS_K=0, LDS_V=NSLOT*SLOTB, LDS_WS=2*NSLOT*SLOTB, LDS_OST=LDS_WS+NW*64*4, LDS_TBL=LDS_OST+NW*4096, LDS_BYTES=LDS_TBL+TBL_BYTES;
__device__ __forceinline__ void glds16(const void*gsrc,unsigned lds_dst){unsigned keep;
  asm volatile("s_mov_b32 %0, m0\n\ts_mov_b32 m0, %2\n\ts_nop 0\n\tglobal_load_lds_dwordx4 %1, off\n\ts_mov_b32 m0, %0":"=&s"(keep):"v"(gsrc),"s"(lds_dst):"memory");}
__device__ __forceinline__ float max3f(float a,float b,float c){float r;asm("v_max3_f32 %0, %1, %2, %3":"=v"(r):"v"(a),"v"(b),"v"(c));return r;}
__device__ __forceinline__ float max2f(float a,float b){float r;asm("v_max_f32_e32 %0, %1, %2":"=v"(r):"v"(a),"v"(b));return r;}
__device__ __forceinline__ float fadd_s(float a,float b){float r;asm("v_add_f32_e32 %0, %1, %2":"=v"(r):"v"(a),"v"(b));return r;}
__device__ __forceinline__ float fsub_s(float a,float b){float r;asm("v_sub_f32_e32 %0, %1, %2":"=v"(r):"v"(a),"v"(b));return r;}
typedef float f32x2_t __attribute__((ext_vector_type(2))); typedef __bf16 bf16x2_t __attribute__((ext_vector_type(2)));
__device__ __forceinline__ unsigned cvtpk_s(float lo,float hi){f32x2_t v={lo,hi};bf16x2_t b=__builtin_convertvector(v,bf16x2_t);return __builtin_bit_cast(unsigned,b);}
#define WAIT_BAR(N) asm volatile("s_waitcnt vmcnt(" #N ") lgkmcnt(0)\n\ts_barrier":::"memory")

__device__ __forceinline__ void qkt(f32x16&p0,f32x16&p1,const char*Kslot,const bf16x8*qr,int r32,int hi){
  const char*kb=Kslot+hi*1024+r32*16;
  #pragma unroll
  for(int d0=0;d0<4;++d0){
    const bf16x8 b0=*reinterpret_cast<const bf16x8*>(kb+d0*2048);
    const bf16x8 b1=*reinterpret_cast<const bf16x8*>(kb+d0*2048+512);
    p0=__builtin_amdgcn_mfma_f32_32x32x16_bf16(b0,qr[d0],p0,0,0,0);p1=__builtin_amdgcn_mfma_f32_32x32x16_bf16(b1,qr[d0],p1,0,0,0);}
}
typedef __attribute__((address_space(3))) const char* lds_cptr;
typedef short v4i16_t __attribute__((ext_vector_type(4)));
__device__ __forceinline__ void kload8(bf16x8*kf,lds_cptr kp){
  kf[0]=*(const __attribute__((address_space(3))) bf16x8*)(kp);      kf[1]=*(const __attribute__((address_space(3))) bf16x8*)(kp+512);
  kf[2]=*(const __attribute__((address_space(3))) bf16x8*)(kp+2048); kf[3]=*(const __attribute__((address_space(3))) bf16x8*)(kp+2560);
  kf[4]=*(const __attribute__((address_space(3))) bf16x8*)(kp+4096); kf[5]=*(const __attribute__((address_space(3))) bf16x8*)(kp+4608);
  kf[6]=*(const __attribute__((address_space(3))) bf16x8*)(kp+6144); kf[7]=*(const __attribute__((address_space(3))) bf16x8*)(kp+6656);
}
__device__ __forceinline__ void kload2(bf16x8*kf,lds_cptr kp,int j){ kf[2*j]=*(const __attribute__((address_space(3))) bf16x8*)(kp+j*2048); kf[2*j+1]=*(const __attribute__((address_space(3))) bf16x8*)(kp+j*2048+512); }
__device__ __forceinline__ s16x4 vtr(lds_cptr p){ return __builtin_bit_cast(s16x4,__builtin_amdgcn_ds_read_tr16_b64_v4i16((__attribute__((address_space(3))) v4i16_t*)p)); }
__device__ __forceinline__ float rowmax(const f32x16&p0,const f32x16&p1){
  float a=max3f(p0[0],p0[1],p1[0]),b=max3f(p0[2],p0[3],p1[1]);a=max3f(a,p1[2],p1[3]);
  #pragma unroll
  for(int r=4;r<16;r+=4){a=max3f(a,p0[r],p0[r+1]);b=max3f(b,p0[r+2],p0[r+3]);a=max3f(a,p1[r],p1[r+1]);b=max3f(b,p1[r+2],p1[r+3]);}
  const float m=max2f(a,b);
  auto rr=__builtin_amdgcn_permlane32_swap(__float_as_uint(m),__float_as_uint(m),false,false);
  return max2f(__uint_as_float(rr[0]),__uint_as_float(rr[1]));
}
__device__ __forceinline__ void pv(f32x16*o,int vb,bf16x8 pa0,bf16x8 pa1,bf16x8 pa2,bf16x8 pa3){
  #pragma unroll
  for(int d0=0;d0<2;++d0){s16x4 lo[4],hi[4];
    #pragma unroll
    for(int ks=0;ks<4;++ks){
      asm volatile("ds_read_b64_tr_b16 %0,%1 offset:%c2":"=&v"(lo[ks]):"v"(vb),"i"(d0*4096+ks*1024):"memory");
      asm volatile("ds_read_b64_tr_b16 %0,%1 offset:%c2":"=&v"(hi[ks]):"v"(vb),"i"(d0*4096+ks*1024+512):"memory");}
    asm volatile("s_waitcnt lgkmcnt(0)":::"memory");SBAR();
    #define PK(k) (bf16x8){lo[k][0],lo[k][1],lo[k][2],lo[k][3],hi[k][0],hi[k][1],hi[k][2],hi[k][3]}
    o[d0]=__builtin_amdgcn_mfma_f32_32x32x16_bf16(pa0,PK(0),o[d0],0,0,0);
    o[d0]=__builtin_amdgcn_mfma_f32_32x32x16_bf16(pa1,PK(1),o[d0],0,0,0);
    o[d0]=__builtin_amdgcn_mfma_f32_32x32x16_bf16(pa2,PK(2),o[d0],0,0,0);
    o[d0]=__builtin_amdgcn_mfma_f32_32x32x16_bf16(pa3,PK(3),o[d0],0,0,0);
    #undef PK
  }
}

#ifndef ATTN_STORE16
#define ATTN_STORE16(p,v) (*(u32x4*)(p)=(v))
#endif
template<int THRL> __device__ __forceinline__ void attn_unit(int b,int h,int qb,const bf16*Q,const bf16*__restrict__ K,const bf16*__restrict__ V,bf16*O,const float*__restrict__ kmean,char*shm){
  const int tid=tidx(),lane=tid&63,r32=lane&31,hi=lane>>5; const int wid=__builtin_amdgcn_readfirstlane(tid>>6);
  const long rowbase=(long)b*SEQ; const int q0=qb*QB;
  const bf16*Qw=Q+(rowbase+q0+wid*QBLK)*QP+h*D;
  const bf16*Kh=K+(long)((b*NHEAD+h)*32)*4096,*Vh=V+(long)((b*NHEAD+h)*32)*4096;
  const unsigned lds0=(unsigned)(uintptr_t)shm;
  float*wsf=(float*)(shm+LDS_WS)+wid*64;
  const bf16*ksrc=Kh+(wid*64+lane)*8;
  const bf16*vsrc=Vh+(wid*64+lane)*8;
  const unsigned kdst=lds0+LDS_K+wid*1024, vdst=lds0+LDS_V+wid*1024;
  #define TMAP(t) (((t)<4)?(4*qb+(t)):((t)-4))
  #define DMA_K(t,slot) glds16(ksrc+(long)TMAP(t)*4096,(unsigned)__builtin_amdgcn_readfirstlane(kdst+(slot)))
  #define DMA_V(t,slot) glds16(vsrc+(long)TMAP(t)*4096,(unsigned)__builtin_amdgcn_readfirstlane(vdst+(slot)))
  const int vb0=(int)(lds0+LDS_V)+((lane>>4)&1)*32+(lane&3)*8+(4*hi+((lane&15)>>2))*64;
  const char*Kbase=shm+LDS_K; bf16x8 kf[8];
  const lds_cptr shm3=(lds_cptr)shm; const lds_cptr kp0=shm3+LDS_K+hi*1024+r32*16; const lds_cptr vp0=shm3+LDS_V+((lane>>4)&1)*32+(lane&3)*8+(4*hi+((lane&15)>>2))*64;
  const int NT=(q0+QB)/KVBLK;
  DMA_K(0,0);DMA_V(0,0);DMA_K(1,SLOTB);
  bf16x8 qr[4];
  #pragma unroll
  for(int d0=0;d0<4;++d0)qr[d0]=*reinterpret_cast<const bf16x8*>(&Qw[(long)r32*QP+d0*16+hi*8]);
  float mhat=0.f,l_reg=0.f;f32x16 o[2];o[0]=f32x16{};o[1]=f32x16{};
  const int qrel=wid*QBLK+r32;
  unsigned selm=0u;
  { f32x16 gacc=f32x16{};
    if(qb>0){ const bool kv_=r32<qb; const float*kmn=kmean+(long)(kv_?r32:0)*NHEAD*D; asm volatile("":"+v"(kmn));
      f32x4 kq[4][2];
      #pragma unroll
      for(int d0=0;d0<4;++d0){ kq[d0][0]=*reinterpret_cast<const f32x4*>(kmn+d0*16+hi*8); kq[d0][1]=*reinterpret_cast<const f32x4*>(kmn+d0*16+hi*8+4); }
      #pragma unroll
      for(int d0=0;d0<4;++d0){ f32x4 k0={0.f,0.f,0.f,0.f},k1={0.f,0.f,0.f,0.f};
        if(kv_){ k0=kq[d0][0]; k1=kq[d0][1]; }
        u32x4 uh,ul; float h0,h1;
        uh.x=cvtpk_s(k0[0],k0[1]); h0=__uint_as_float(uh.x<<16); h1=__uint_as_float(uh.x&0xffff0000u); ul.x=cvtpk_s(k0[0]-h0,k0[1]-h1);
        uh.y=cvtpk_s(k0[2],k0[3]); h0=__uint_as_float(uh.y<<16); h1=__uint_as_float(uh.y&0xffff0000u); ul.y=cvtpk_s(k0[2]-h0,k0[3]-h1);
        uh.z=cvtpk_s(k1[0],k1[1]); h0=__uint_as_float(uh.z<<16); h1=__uint_as_float(uh.z&0xffff0000u); ul.z=cvtpk_s(k1[0]-h0,k1[1]-h1);
        uh.w=cvtpk_s(k1[2],k1[3]); h0=__uint_as_float(uh.w<<16); h1=__uint_as_float(uh.w&0xffff0000u); ul.w=cvtpk_s(k1[2]-h0,k1[3]-h1);
        gacc=__builtin_amdgcn_mfma_f32_32x32x16_bf16(__builtin_bit_cast(bf16x8,uh),qr[d0],gacc,0,0,0);
        gacc=__builtin_amdgcn_mfma_f32_32x32x16_bf16(__builtin_bit_cast(bf16x8,ul),qr[d0],gacc,0,0,0); } }
    float gt[8];
    #pragma unroll
    for(int i=0;i<4;++i){ const float own=gacc[i], oth=__shfl_xor(own,32); gt[i]=hi?oth:own; gt[4+i]=hi?own:oth; }
    #pragma unroll
    for(int n=0;n<8;++n) if(n>=qb) gt[n]=-INFINITY;
    #pragma unroll
    for(int n=0;n<8;++n){ int rk=0;
      #pragma unroll
      for(int m=0;m<8;++m) rk+=(m<qb&&(gt[m]>gt[n]||(gt[m]==gt[n]&&m<n)))?1:0;
      if(n<qb&&(qb<=3||rk<3)) selm|=(1u<<n); } }
  const int qabs=q0+qrel, cpy=(YOFF-qabs)&3;
  const lds_cptr tb_sel=shm3+(LDS_TBL+cpy*TARRB+4*(YOFF-qabs+4*hi-cpy)), tb_neg=shm3+(LDS_TBL+4*TARRB);
  typedef __attribute__((address_space(3))) const f32x4* lds_f4p;
  #define BIASLD(P0,P1,t) do{ const int tt_=TMAP(t); const bool on_=((t)<4)||((selm>>(tt_>>2))&1u); const lds_cptr ba_=on_?(tb_sel+256*tt_):tb_neg; \
    _Pragma("unroll") for(int g_=0;g_<4;++g_){ const f32x4 x0_=*(lds_f4p)(ba_+32*g_), x1_=*(lds_f4p)(ba_+32*g_+128); \
      _Pragma("unroll") for(int i_=0;i_<4;++i_){ P0[4*g_+i_]=x0_[i_]-mhat; P1[4*g_+i_]=x1_[i_]-mhat; } } }while(0)
  #define CMASK(P0,P1,t) do{ if((t)<4){ int qr_=qrel; asm volatile("":"+v"(qr_)); cmask(P0,P1,(t),qr_,hi); } }while(0)
  bool resc=false;
  #define START(P0,P1) do{ const float rm=rowmax(P0,P1); resc=false; \
    { const float dl=rm; mhat=fadd_s(mhat,dl); \
      _Pragma("unroll") for(int r=0;r<16;++r){P0[r]=fsub_s(P0[r],dl);P1[r]=fsub_s(P1[r],dl);} } \
    _Pragma("unroll") for(int r=0;r<16;++r)P0[r]=__builtin_amdgcn_exp2f(P0[r]); }while(0)
  #define RESC() do{ if(resc){ asm volatile("s_waitcnt lgkmcnt(0)":::"memory"); \
      _Pragma("unroll") for(int d_=0;d_<2;++d_) _Pragma("unroll") for(int r=0;r<16;++r)o[d_][r]*=wsf[crow(r,hi)]; } }while(0)
  f32x16 pA0,pA1,pB0,pB1;
  int sl_prev=0,sl_cur=0,sl_next=SLOTB;
  #define ROT() do{sl_prev=sl_cur;sl_cur=sl_next;sl_next=(sl_next==(NSLOT-1)*SLOTB)?0:sl_next+SLOTB;}while(0)
  DMA_K(2,2*SLOTB);
  WAIT_BAR(3);
  BIASLD(pA0,pA1,0); qkt(pA0,pA1,Kbase,qr,r32,hi);asm volatile("s_nop 15\n\ts_nop 7":"+v"(pA0),"+v"(pA1));CMASK(pA0,pA1,0);
  START(pA0,pA1);
  _Pragma("unroll") for(int r=0;r<16;++r)pA1[r]=__builtin_amdgcn_exp2f(pA1[r]);
  WAIT_BAR(0);
  DMA_K(3,0);DMA_V(1,SLOTB);
  ROT();
  kload8(kf,kp0+sl_cur);
  WAIT_BAR(2);
  s16x4 vlo[8],vhi[8]; u32x4 pw0,pw1,pw2,pw3;
  #define PKW(P,B) cvtpk_s(P[B],P[B+1])
  #define PAF(k) __builtin_bit_cast(bf16x8,pw##k)
  #define VFR(i) (bf16x8){vlo[i][0],vlo[i][1],vlo[i][2],vlo[i][3],vhi[i][0],vhi[i][1],vhi[i][2],vhi[i][3]}
  #define PIN(x) asm volatile("":"+v"(x))
  #define MX3(a,b,c) __builtin_fmaxf(__builtin_fmaxf((a),(b)),(c))
  #define GAPA(MF,A0,A1,A2,A3,W0,W1,PW) do{ MF; sacc+=A0; sacc+=A1; sacc+=A2; sacc+=A3; PIN(sacc); W0; W1; PIN(PW); SBAR(); }while(0)
  #define EX(v) __builtin_amdgcn_exp2f(v)
  #define GAPB(MF,X,B) do{ MF; X[B]=EX(X[B]); X[B+1]=EX(X[B+1]); X[B+2]=EX(X[B+2]); X[B+3]=EX(X[B+3]); PIN(X); SBAR(); }while(0)
  #define VRD(i) do{ vlo[i]=vtr(vp_+(((i)>>2)*4096+((i)&3)*1024)); vhi[i]=vtr(vp_+(((i)>>2)*4096+((i)&3)*1024+512)); }while(0)
  #define KRD(G,j) do{ if(G){ kload2(kf,kp0+sl_next,j); SBAR(); } }while(0)
  #define STEP(C0,C1,P0,P1,t,GK,GV,GL) do{ SBAR(); \
    BIASLD(C0,C1,t); SBAR(); \
    const lds_cptr vp_=vp0+sl_prev; \
    VRD(0); SBAR(); float sacc=(P0[0]+P0[1]); \
    GAPA(C0=__builtin_amdgcn_mfma_f32_32x32x16_bf16(kf[0],qr[0],C0,0,0,0), P0[2],P0[3],P0[4],P0[5],     pw0[0]=PKW(P0,0), pw0[1]=PKW(P0,2), pw0); \
    VRD(4); SBAR(); GAPA(C1=__builtin_amdgcn_mfma_f32_32x32x16_bf16(kf[1],qr[0],C1,0,0,0), P0[6],P0[7],P0[8],P0[9],     pw0[2]=PKW(P0,4), pw0[3]=PKW(P0,6), pw0); \
    VRD(1); SBAR(); GAPA(C0=__builtin_amdgcn_mfma_f32_32x32x16_bf16(kf[2],qr[1],C0,0,0,0),   P0[10],P0[11],P0[12],P0[13], pw1[0]=PKW(P0,8), pw1[1]=PKW(P0,10), pw1); \
    VRD(5); SBAR(); GAPA(C1=__builtin_amdgcn_mfma_f32_32x32x16_bf16(kf[3],qr[1],C1,0,0,0),   P0[14],P0[15],P1[0],P1[1],   pw1[2]=PKW(P0,12),pw1[3]=PKW(P0,14), pw1); \
    VRD(2); SBAR(); GAPA(C0=__builtin_amdgcn_mfma_f32_32x32x16_bf16(kf[4],qr[2],C0,0,0,0),   P1[2],P1[3],P1[4],P1[5],     pw2[0]=PKW(P1,0), pw2[1]=PKW(P1,2), pw2); \
    VRD(6); SBAR(); GAPA(C1=__builtin_amdgcn_mfma_f32_32x32x16_bf16(kf[5],qr[2],C1,0,0,0),   P1[6],P1[7],P1[8],P1[9],     pw2[2]=PKW(P1,4), pw2[3]=PKW(P1,6), pw2); \
    VRD(3); SBAR(); GAPA(C0=__builtin_amdgcn_mfma_f32_32x32x16_bf16(kf[6],qr[3],C0,0,0,0),   P1[10],P1[11],P1[12],P1[13], pw3[0]=PKW(P1,8), pw3[1]=PKW(P1,10), pw3); \
    VRD(7); SBAR(); GAPA(C1=__builtin_amdgcn_mfma_f32_32x32x16_bf16(kf[7],qr[3],C1,0,0,0),   P1[14],P1[15],0.f,0.f,       pw3[2]=PKW(P1,12),pw3[3]=PKW(P1,14), pw3); \
    l_reg+=sacc; \
    if(GK){DMA_K((t)+3,sl_cur);} if(GV){DMA_V((t)+1,sl_next);} \
    CMASK(C0,C1,t); \
    { float a=MX3(C0[0],C0[1],C1[0]),b=MX3(C0[2],C0[3],C1[1]); a=MX3(a,C1[2],C1[3]); \
      _Pragma("unroll") for(int r=4;r<16;r+=4){a=MX3(a,C0[r],C0[r+1]);b=MX3(b,C0[r+2],C0[r+3]);a=MX3(a,C1[r],C1[r+1]);b=MX3(b,C1[r+2],C1[r+3]);} \
      float rm=__builtin_fmaxf(a,b); { auto rr=__builtin_amdgcn_permlane32_swap(__float_as_uint(rm),__float_as_uint(rm),false,false); rm=__builtin_fmaxf(__uint_as_float(rr[0]),__uint_as_float(rr[1])); } \
      resc=false; \
      if(__builtin_expect(__any(rm>(float)THRL),0)){ const float dl=__builtin_fmaxf(rm,0.f); mhat+=dl; \
        _Pragma("unroll") for(int r=0;r<16;++r){C0[r]-=dl;C1[r]-=dl;} \
        const float f=__builtin_amdgcn_exp2f(-dl); l_reg*=f; if(hi==0)wsf[r32]=f; resc=true; } } \
    SBAR(); \
    GAPB(o[0]=__builtin_amdgcn_mfma_f32_32x32x16_bf16(PAF(0),VFR(0),o[0],0,0,0), C0,0); \
    GAPB(o[1]=__builtin_amdgcn_mfma_f32_32x32x16_bf16(PAF(0),VFR(4),o[1],0,0,0), C0,4); \
    KRD(GL,0); GAPB(o[0]=__builtin_amdgcn_mfma_f32_32x32x16_bf16(PAF(1),VFR(1),o[0],0,0,0), C0,8); \
    KRD(GL,1); GAPB(o[1]=__builtin_amdgcn_mfma_f32_32x32x16_bf16(PAF(1),VFR(5),o[1],0,0,0), C0,12); \
    KRD(GL,2); GAPB(o[0]=__builtin_amdgcn_mfma_f32_32x32x16_bf16(PAF(2),VFR(2),o[0],0,0,0), C1,0); \
    KRD(GL,3); GAPB(o[1]=__builtin_amdgcn_mfma_f32_32x32x16_bf16(PAF(2),VFR(6),o[1],0,0,0), C1,4); \
    GAPB(o[0]=__builtin_amdgcn_mfma_f32_32x32x16_bf16(PAF(3),VFR(3),o[0],0,0,0), C1,8); \
    GAPB(o[1]=__builtin_amdgcn_mfma_f32_32x32x16_bf16(PAF(3),VFR(7),o[1],0,0,0), C1,12); \
    }while(0)
  int t=1;
  for(;t+5<NT;t+=2){
    STEP(pB0,pB1,pA0,pA1,t,true,true,true);     WAIT_BAR(2); RESC(); ROT();
    STEP(pA0,pA1,pB0,pB1,t+1,true,true,true);   WAIT_BAR(2); RESC(); ROT();
  }
  #define ENDW(tt) do{ if((tt)+3<NT){WAIT_BAR(2);} else if((tt)+2<NT){WAIT_BAR(1);} else {WAIT_BAR(0);} }while(0)
  for(;t+1<NT;t+=2){
    STEP(pB0,pB1,pA0,pA1,t,(t+3<NT),(t+1<NT),(t+1<NT));       ENDW(t);   RESC(); ROT();
    STEP(pA0,pA1,pB0,pB1,t+1,(t+4<NT),(t+2<NT),(t+2<NT));     ENDW(t+1); RESC(); ROT();
  }
  STEP(pB0,pB1,pA0,pA1,NT-1,false,false,false); RESC();
  { float sacc=pB0[0]+pB0[1]; _Pragma("unroll") for(int r=2;r<16;++r)sacc+=pB0[r]; _Pragma("unroll") for(int r=0;r<16;++r)sacc+=pB1[r]; l_reg+=sacc;
    pw0=(u32x4){PKW(pB0,0),PKW(pB0,2),PKW(pB0,4),PKW(pB0,6)};pw1=(u32x4){PKW(pB0,8),PKW(pB0,10),PKW(pB0,12),PKW(pB0,14)};pw2=(u32x4){PKW(pB1,0),PKW(pB1,2),PKW(pB1,4),PKW(pB1,6)};pw3=(u32x4){PKW(pB1,8),PKW(pB1,10),PKW(pB1,12),PKW(pB1,14)};
    SBAR(); pv(o,vb0+sl_cur,PAF(0),PAF(1),PAF(2),PAF(3)); }
  #undef PKW
  #undef PAF
  #undef VFR
  #undef PIN
  #undef MX3
  #undef GAPA
  #undef GAPB
  #undef EX
  #undef VRD
  #undef KRD
  #undef STEP
  #undef ENDW
  {auto rr=__builtin_amdgcn_permlane32_swap(__float_as_uint(l_reg),__float_as_uint(l_reg),false,false);l_reg=__uint_as_float(rr[0])+__uint_as_float(rr[1]);}
  if(hi==0)wsf[32+r32]=l_reg;asm volatile("s_waitcnt lgkmcnt(0)":::"memory");
  float rli[16];
  #pragma unroll
  for(int r=0;r<16;++r)rli[r]=__builtin_amdgcn_rcpf(wsf[32+crow(r,hi)]);
  bf16*Ow=O+(rowbase+q0+wid*QBLK)*QP+h*D;
  { bf16*stg=(bf16*)(shm+LDS_OST)+wid*2048;
    #pragma unroll
    for(int r=0;r<16;++r){const int orow=crow(r,hi);
      #pragma unroll
      for(int d0=0;d0<2;++d0)stg[orow*64+d0*32+r32]=(bf16)(cvtpk_s(o[d0][r]*rli[r],0.f)&0xffffu);}
    asm volatile("s_waitcnt lgkmcnt(0)":::"memory");
    #pragma unroll
    for(int i=0;i<4;++i){const int row=i*8+(lane>>3),ch=lane&7; const u32x4 v=*(const u32x4*)(stg+row*64+ch*8); ATTN_STORE16(Ow+(long)row*QP+ch*8,v);} }
  asm volatile("s_waitcnt lgkmcnt(0)\n\ts_barrier":::"memory");
  #undef DMA_K
  #undef DMA_V
  #undef TMAP
  #undef BIASLD
  #undef CMASK
  #undef START
  #undef RESC
  #undef ROT
}
constexpr int ATTN_LDS_BYTES=LDS_BYTES;
__device__ __forceinline__ void fill_tables(char*shm,const float*__restrict__ relb){
  float*tb=(float*)(shm+LDS_TBL);
  for(int i=tidx();i<4*TARR+64;i+=512){ const int c=i/TARR, z=i-c*TARR, d=YOFF-z-c; tb[i]=(c==4)?-INFINITY:((d>=0&&d<SEQ)?relb[d]:0.f); }
}
#undef SBAR
#undef WAIT_BAR
}

namespace ssd {
typedef float f32x16 __attribute__((ext_vector_type(16)));
typedef LAS unsigned char* lptr;
constexpr int LCH = 128, NCH = SEQ / LCH;
constexpr int ROWB = 272;
constexpr size_t TILE_E = 128 * 128;
__device__ __forceinline__ int crow(int r, int hi) { return (r & 3) + 8 * (r >> 2) + 4 * hi; }
__device__ __forceinline__ unsigned pk(float lo, float hi) { return pg8::cvt_pk_bf16(lo, hi); }
__device__ __forceinline__ float bflo(unsigned w) { return __uint_as_float(w << 16); }
__device__ __forceinline__ float bfhi(unsigned w) { return __uint_as_float(w & 0xffff0000u); }

__device__ __forceinline__ void pre_unit(int unit, lptr lds, const bf16* __restrict__ brw, const bf16* __restrict__ crw, const float* __restrict__ conv_w, const float* __restrict__ conv_b,
                                         bf16* __restrict__ CBm, bf16* __restrict__ Ccg, bf16* __restrict__ BcT) {
    const int tid = tidx(), lane = tid & 63, wv = __builtin_amdgcn_readfirstlane(tid >> 6);
    const int g = unit & 3, c = (unit >> 2) & 15, b = unit >> 6;
    const size_t tbase = (size_t)unit * TILE_E;
    lptr CcL = lds, BcL = lds + 128 * ROWB, CBL = lds + 2 * 128 * ROWB;
    {
        const int arr = tid >> 8, n = tid & 127, lh = (tid >> 7) & 1;
        const bf16* src = (arr ? crw : brw) + (size_t)(b * SEQ + c * LCH) * 512 + g * 128 + n;
        const int chn = (arr ? 2560 : 2048) + g * 128 + n;
        const float w0 = conv_w[chn], w1 = conv_w[CONVD + chn], w2 = conv_w[2 * CONVD + chn], w3 = conv_w[3 * CONVD + chn], cb = conv_b[chn];
        const int l0 = lh * 64; const bool has_prev = (c > 0) || (lh > 0);
        unsigned short raw[67];
#pragma unroll
        for (int i = 0; i < 67; ++i) { const int idx = (i >= 3 || has_prev) ? (l0 - 3 + i) : 0; raw[i] = src[(long)idx * 512]; }
        float h0 = has_prev ? bf2f(raw[0]) : 0.f, h1 = has_prev ? bf2f(raw[1]) : 0.f, h2 = has_prev ? bf2f(raw[2]) : 0.f;
        lptr dstL = (arr ? CcL : BcL) + n * 2;
#pragma unroll
        for (int l8 = 0; l8 < 64; l8 += 8) {
            float v[8];
#pragma unroll
            for (int i = 0; i < 8; ++i) { const float cur = bf2f(raw[3 + l8 + i]); v[i] = siluf(cb + w0 * h0 + w1 * h1 + w2 * h2 + w3 * cur); h0 = h1; h1 = h2; h2 = cur; }
            unsigned pw[4];
#pragma unroll
            for (int i = 0; i < 4; ++i) pw[i] = pk(v[2 * i], v[2 * i + 1]);
#pragma unroll
            for (int i = 0; i < 8; ++i) *(LAS unsigned short*)(dstL + (l0 + l8 + i) * ROWB) = (unsigned short)((i & 1) ? (pw[i >> 1] >> 16) : (pw[i >> 1] & 0xffffu));
            if (!arr) { u32x4 o; o.x = pw[0]; o.y = pw[1]; o.z = pw[2]; o.w = pw[3]; const int l = l0 + l8;
                *(u32x4*)(BcT + tbase + ((size_t)(((n >> 5) * 8 + (l >> 4)) * 64 + (n & 31) + 32 * ((l >> 3) & 1))) * 8) = o; }
        }
    }
    __syncthreads();
    {
#pragma unroll
        for (int f = 0; f < 4; ++f) { const int fid = tid + 512 * f, ln = fid & 63, q = (fid >> 6) & 7, lb = fid >> 9, l = lb * 32 + (ln & 31), hf = ln >> 5;
            const u32x2 x0 = *(const LAS u32x2*)(CcL + l * ROWB + (16 * q + 4 * hf) * 2), x1 = *(const LAS u32x2*)(CcL + l * ROWB + (16 * q + 8 + 4 * hf) * 2);
            u32x4 o; o.x = x0.x; o.y = x0.y; o.z = x1.x; o.w = x1.y; *(u32x4*)(Ccg + tbase + (size_t)fid * 8) = o; }
    }
    {
        const int r32 = lane & 31, hi = lane >> 5, rt = wv >> 1;
#pragma unroll
        for (int cc = 0; cc < 2; ++cc) {
            const int ct = 2 * (wv & 1) + cc;
            if (ct <= rt) {
                f32x16 acc = {};
#pragma unroll
                for (int ks = 0; ks < 8; ++ks) {
                    const bf16x8 a = *(const LAS bf16x8*)(CcL + (32 * rt + r32) * ROWB + (16 * ks + 8 * hi) * 2);
                    const bf16x8 bb = *(const LAS bf16x8*)(BcL + (32 * ct + r32) * ROWB + (16 * ks + 8 * hi) * 2);
                    acc = __builtin_amdgcn_mfma_f32_32x32x16_bf16(a, bb, acc, 0, 0, 0);
                }
#pragma unroll
                for (int r = 0; r < 16; ++r) *(LAS unsigned short*)(CBL + (32 * rt + crow(r, hi)) * ROWB + (32 * ct + r32) * 2) = f2bf(acc[r]);
            }
        }
    }
    __syncthreads();
    {
#pragma unroll
        for (int f = 0; f < 4; ++f) { const int fid = tid + 512 * f, ln = fid & 63, ks = (fid >> 6) & 7, rt = fid >> 9;
            if ((ks >> 1) <= rt) { const u32x4 o = *(const LAS u32x4*)(CBL + (32 * rt + (ln & 31)) * ROWB + (16 * ks + 8 * (ln >> 5)) * 2); *(u32x4*)(CBm + tbase + (size_t)fid * 8) = o; } }
    }
    __syncthreads();
}

constexpr int U_XS = 0, U_ST = 64 * ROWB, STP = 136, U_HF = 2 * 64 * ROWB, U_SC = U_HF + 2 * 16384, U_BYTES = U_SC + 2 * 1536;

__device__ __forceinline__ void main_pair(int bh, lptr lds_wg, const bf16* __restrict__ cat, bf16* __restrict__ yout, float* __restrict__ ssq, const bf16* __restrict__ xs, const float* __restrict__ dtraw, const bf16* __restrict__ CBm, const bf16* __restrict__ Ccg, const bf16* __restrict__ BcT,
                                          const float* __restrict__ conv_w, const float* __restrict__ conv_b, const float* __restrict__ dt_bias, const float* __restrict__ a_log, const float* __restrict__ d_skip) {
    const int tid = tidx(), lane = tid & 63, wave = __builtin_amdgcn_readfirstlane(tid >> 6), w = wave & 3, un = wave >> 2, lt = tid & 255;
    const int r32 = lane & 31, hi = lane >> 5;
    const int h = bh & 31, b = bh >> 5, g = h >> 3;
    lptr L = lds_wg + un * U_BYTES;
    const float A2 = -__expf(a_log[h]) * LOG2E, dtb = dt_bias[h], dsk = d_skip[h];
    const int cp = lt & 63;
    f32x16 Hs[2]; Hs[0] = f32x16{}; Hs[1] = f32x16{};
    const int oR = (32 * w + (lane >> 3)) * CATP + h * 64 + 8 * (lane & 7), oX = (32 * w - 3) * SI + h * 64 + cp;
    float dr0 = 0.f, dr1 = 0.f;
#define SSD_PREF(cn) do { const size_t t0_ = (size_t)b * SEQ + (size_t)(cn) * LCH; if (w == 0) { dr0 = dtraw[(t0_ + 2 * lane) * 32 + h]; dr1 = dtraw[(t0_ + 2 * lane + 1) * 32 + h]; } } while (0)
    SSD_PREF(0);
    for (int c = 0; c < NCH; ++c) {
        const size_t tok0 = (size_t)b * SEQ + (size_t)c * LCH;
        const size_t tbase = ((size_t)(b * NCH + c) * 4 + g) * TILE_E;
        LAS float* SC = (LAS float*)(L + U_SC + (c & 1) * 1536);
        u32x4 cbf[8]; u32x2 ccf[16]; u32x4 zq[4]; unsigned short rawx[35];
        const float* cwp = conv_w + h * 64; const float* cbp_ = conv_b + h * 64; asm volatile("" : "+s"(cwp), "+s"(cbp_));
        const float cw0 = cwp[cp], cw1 = cwp[CONVD + cp], cw2 = cwp[2 * CONVD + cp], cw3 = cwp[3 * CONVD + cp], cbias = cbp_[cp];
        { const bf16* xb_ = xs + tok0 * SI; const bool hp_ = (c > 0) || (w > 0); int ox_ = oX;
#pragma unroll
          for (int i_ = 0; i_ < 35; ++i_) { rawx[i_] = (i_ >= 3 || hp_) ? xb_[ox_] : (unsigned short)0; ox_ += SI; asm volatile("" : "+v"(ox_)); } }
        { const bf16* cbb = CBm + tbase;
#pragma unroll
          for (int ks = 0; ks < 8; ++ks) cbf[ks] = (ks < 2 * w + 2) ? *(const u32x4*)(cbb + ((w * 8 + ks) * 64 + lane) * 8) : (u32x4){0u, 0u, 0u, 0u};
          if (c > 0) { const bf16* ccb = Ccg + tbase;
#pragma unroll
              for (int q = 0; q < 8; ++q) { const u32x4 t_ = *(const u32x4*)(ccb + ((w * 8 + q) * 64 + lane) * 8); ccf[2 * q].x = t_.x; ccf[2 * q].y = t_.y; ccf[2 * q + 1].x = t_.z; ccf[2 * q + 1].y = t_.w; } }
        }
        if (w == 0) {
            const float d0 = softplus_fast(dr0 + dtb), d1 = softplus_fast(dr1 + dtb);
            const float a0 = d0 * A2, a1 = d1 * A2; float s = a0 + a1;
#pragma unroll
            for (int o = 1; o < 64; o <<= 1) { const float t = __shfl_up(s, o); if (lane >= o) s += t; }
            const float aend_ = __shfl(s, 63);
            SC[2 * lane] = s - a1; SC[2 * lane + 1] = s; SC[128 + 2 * lane] = (s - a1) - __builtin_amdgcn_logf(d0); SC[129 + 2 * lane] = s - __builtin_amdgcn_logf(d1);
            SC[256 + 2 * lane] = d0 * __builtin_amdgcn_exp2f(aend_ - (s - a1)); SC[257 + 2 * lane] = d1 * __builtin_amdgcn_exp2f(aend_ - s);
        }
        __syncthreads();
        {
            float h0 = bf2f(rawx[0]), h1 = bf2f(rawx[1]), h2 = bf2f(rawx[2]);
#pragma unroll
            for (int l8 = 0; l8 < 32; l8 += 8) {
                float v[8];
#pragma unroll
                for (int i = 0; i < 8; ++i) { const float cur = bf2f(rawx[3 + l8 + i]); v[i] = silu_fast(cbias + cw0 * h0 + cw1 * h1 + cw2 * h2 + cw3 * cur); h0 = h1; h1 = h2; h2 = cur; }
                u32x4 o0; o0.x = pk(v[0], v[1]); o0.y = pk(v[2], v[3]); o0.z = pk(v[4], v[5]); o0.w = pk(v[6], v[7]);
                *(LAS u32x4*)(L + U_XS + cp * ROWB + (32 * w + l8) * 2) = o0;
            }
        }
        if (c + 1 < NCH) SSD_PREF(c + 1);
        __syncthreads();
        f32x16 Y[2]; Y[0] = f32x16{}; Y[1] = f32x16{};
        if (c > 0) {
            lptr HFr = L + U_HF + ((c - 1) & 1) * 16384;
#pragma unroll
            for (int wb = 0; wb < 4; ++wb)
#pragma unroll
                for (int s = 0; s < 2; ++s) {
                    u32x4 au; au.x = ccf[2 * (2 * wb + s)].x; au.y = ccf[2 * (2 * wb + s)].y; au.z = ccf[2 * (2 * wb + s) + 1].x; au.w = ccf[2 * (2 * wb + s) + 1].y; const bf16x8 cfr = __builtin_bit_cast(bf16x8, au);
#pragma unroll
                    for (int pb = 0; pb < 2; ++pb) { const bf16x8 hb = *(const LAS bf16x8*)(HFr + (((wb * 2 + pb) * 2 + s) * 64 + lane) * 16); Y[pb] = __builtin_amdgcn_mfma_f32_32x32x16_bf16(hb, cfr, Y[pb], 0, 0, 0); }
                    __builtin_amdgcn_sched_barrier(0);
                }
            const float e = __builtin_amdgcn_exp2f(SC[32 * w + r32]);
#pragma unroll
            for (int r = 0; r < 16; ++r) { Y[0][r] *= e; Y[1][r] *= e; }
        }
        { const bf16* zb = cat + tok0 * CATP + 1024;
#pragma unroll
          for (int i = 0; i < 4; ++i) zq[i] = *(const u32x4*)(zb + (oR + 8 * i * CATP)); }
        u32x4 btf[8];
        { const bf16* bb = BcT + tbase;
#pragma unroll
          for (int ks = 0; ks < 8; ++ks) btf[ks] = *(const u32x4*)(bb + ((w * 8 + ks) * 64 + lane) * 8); }
        {
            const float al = SC[32 * w + r32];
#pragma unroll
            for (int ks = 0; ks < 8; ++ks) if (ks < 2 * w + 2) {
                const u32x4 cu = cbf[ks];
                const f32x4 q0 = *(const LAS f32x4*)(SC + 128 + 16 * ks + 8 * hi), q1 = *(const LAS f32x4*)(SC + 128 + 16 * ks + 8 * hi + 4);
                float m[8];
                m[0] = bflo(cu.x) * __builtin_amdgcn_exp2f(al - q0[0]); m[1] = bfhi(cu.x) * __builtin_amdgcn_exp2f(al - q0[1]); m[2] = bflo(cu.y) * __builtin_amdgcn_exp2f(al - q0[2]); m[3] = bfhi(cu.y) * __builtin_amdgcn_exp2f(al - q0[3]);
                m[4] = bflo(cu.z) * __builtin_amdgcn_exp2f(al - q1[0]); m[5] = bfhi(cu.z) * __builtin_amdgcn_exp2f(al - q1[1]); m[6] = bflo(cu.w) * __builtin_amdgcn_exp2f(al - q1[2]); m[7] = bfhi(cu.w) * __builtin_amdgcn_exp2f(al - q1[3]);
                if (ks >= 2 * w) {
                    int dd = r32 - (16 * ks + 8 * hi - 32 * w); asm volatile("" : "+v"(dd));
#pragma unroll
                    for (int j = 0; j < 8; ++j) { if (j > dd) m[j] = 0.f; if (j == dd) m[j] += dsk; }
                }
                u32x4 mu; mu.x = pk(m[0], m[1]); mu.y = pk(m[2], m[3]); mu.z = pk(m[4], m[5]); mu.w = pk(m[6], m[7]); const bf16x8 mf = __builtin_bit_cast(bf16x8, mu);
#pragma unroll
                for (int pb = 0; pb < 2; ++pb) { const bf16x8 xb = *(const LAS bf16x8*)(L + U_XS + (32 * pb + r32) * ROWB + (16 * ks + 8 * hi) * 2); Y[pb] = __builtin_amdgcn_mfma_f32_32x32x16_bf16(xb, mf, Y[pb], 0, 0, 0); }
                __builtin_amdgcn_sched_barrier(0);
            }
        }
        {
            lptr ST = L + U_ST + 32 * w * STP;
#pragma unroll
            for (int i = 0; i < 4; ++i) { lptr p_ = ST + (8 * i + (lane >> 3)) * STP + 16 * (lane & 7); u32x2 a_, b_; a_.x = zq[i].x; a_.y = zq[i].y; b_.x = zq[i].z; b_.y = zq[i].w; *(LAS u32x2*)p_ = a_; *(LAS u32x2*)(p_ + 8) = b_; }
            asm volatile("s_waitcnt lgkmcnt(0)" ::: "memory");
            float sq = 0.f; lptr rowp = ST + r32 * STP + 8 * hi;
#pragma unroll
            for (int pb = 0; pb < 2; ++pb)
#pragma unroll
                for (int gq = 0; gq < 4; ++gq) { const u32x2 zz = *(const LAS u32x2*)(rowp + 64 * pb + 16 * gq); u32x2 o;
                    const float y0 = Y[pb][4 * gq] * silu_fast(bflo(zz.x)), y1 = Y[pb][4 * gq + 1] * silu_fast(bfhi(zz.x)), y2 = Y[pb][4 * gq + 2] * silu_fast(bflo(zz.y)), y3 = Y[pb][4 * gq + 3] * silu_fast(bfhi(zz.y));
                    sq += (y0 * y0 + y1 * y1) + (y2 * y2 + y3 * y3); o.x = pk(y0, y1); o.y = pk(y2, y3);
                    *(LAS u32x2*)(rowp + 64 * pb + 16 * gq) = o; }
            sq += __shfl_xor(sq, 32);
            if (hi == 0) (ssq + tok0 * 32)[(32 * w + r32) * 32 + h] = sq;
            asm volatile("s_waitcnt lgkmcnt(0)" ::: "memory");
            bf16* yb_ = yout + tok0 * CATP + 1024;
#pragma unroll
            for (int i = 0; i < 4; ++i) { const lptr p_ = ST + (8 * i + (lane >> 3)) * STP + 16 * (lane & 7); const u32x2 a_ = *(const LAS u32x2*)p_, b_ = *(const LAS u32x2*)(p_ + 8);
                u32x4 o; o.x = a_.x; o.y = a_.y; o.z = b_.x; o.w = b_.y; *(u32x4*)(yb_ + (oR + 8 * i * CATP)) = o; }
        }
        {
            const float dec = __builtin_amdgcn_exp2f(SC[127]);
#pragma unroll
            for (int r = 0; r < 16; ++r) { Hs[0][r] *= dec; Hs[1][r] *= dec; }
#pragma unroll
            for (int ks = 0; ks < 8; ++ks) {
                const f32x4 f0 = *(const LAS f32x4*)(SC + 256 + 16 * ks + 8 * hi), f1 = *(const LAS f32x4*)(SC + 256 + 16 * ks + 8 * hi + 4);
                const u32x4 bu = btf[ks]; u32x4 au;
                au.x = pk(bflo(bu.x) * f0[0], bfhi(bu.x) * f0[1]); au.y = pk(bflo(bu.y) * f0[2], bfhi(bu.y) * f0[3]); au.z = pk(bflo(bu.z) * f1[0], bfhi(bu.z) * f1[1]); au.w = pk(bflo(bu.w) * f1[2], bfhi(bu.w) * f1[3]);
                const bf16x8 a = __builtin_bit_cast(bf16x8, au);
#pragma unroll
                for (int pb = 0; pb < 2; ++pb) { const bf16x8 xb = *(const LAS bf16x8*)(L + U_XS + (32 * pb + r32) * ROWB + (16 * ks + 8 * hi) * 2); Hs[pb] = __builtin_amdgcn_mfma_f32_32x32x16_bf16(a, xb, Hs[pb], 0, 0, 0); }
                __builtin_amdgcn_sched_barrier(0);
            }
            if (c + 1 < NCH) {
                lptr HFw = L + U_HF + (c & 1) * 16384;
#pragma unroll
                for (int pb = 0; pb < 2; ++pb)
#pragma unroll
                    for (int s = 0; s < 2; ++s) { u32x4 f; f.x = pk(Hs[pb][8 * s], Hs[pb][8 * s + 1]); f.y = pk(Hs[pb][8 * s + 2], Hs[pb][8 * s + 3]); f.z = pk(Hs[pb][8 * s + 4], Hs[pb][8 * s + 5]); f.w = pk(Hs[pb][8 * s + 6], Hs[pb][8 * s + 7]);
                        *(LAS u32x4*)(HFw + (((w * 2 + pb) * 2 + s) * 64 + lane) * 16) = f; }
            }
        }
    }
#undef SSD_PREF
    __syncthreads();
}
}

constexpr int CW_BAR = 4096;
#define RLX_AGENT __ATOMIC_RELAXED, __HIP_MEMORY_SCOPE_AGENT
#define LDS_WAIT() asm volatile("s_waitcnt lgkmcnt(0)" ::: "memory")
#define VM_WAIT() asm volatile("s_waitcnt vmcnt(0)" ::: "memory")
#define XB_TMO      128
#define XB_XCNT(j)  (256  + 64 * (j))
#define XB_XSUB(j)  (1280 + 64 * (j))
#define XB_XGEN(j)  (2304 + 64 * (j))
#define XB_TOP      3328
#define XB_TOPGEN   3392
#define XCD_BAR_WORDS 3456
#define XB_SPIN_CAP (1u << 27)
__device__ __forceinline__ unsigned xb_ld(unsigned* p)              { return __hip_atomic_load(p, __ATOMIC_RELAXED, __HIP_MEMORY_SCOPE_AGENT); }
__device__ __forceinline__ unsigned xb_add(unsigned* p, unsigned v) { return __hip_atomic_fetch_add(p, v, __ATOMIC_RELAXED, __HIP_MEMORY_SCOPE_AGENT); }
__device__ __forceinline__ unsigned xb_xcc_id() { return (unsigned)__builtin_amdgcn_s_getreg((3 << 11) | 20) & 0xFu; }
#define XB_SPIN(cond, bar) do { unsigned _sp = 0; while (cond) { __builtin_amdgcn_s_sleep(1); \
    if ((++_sp & 255u) == 0u) { if (xb_ld(&(bar)[XB_TMO])) break; if (_sp > XB_SPIN_CAP) { atomicAdd(&(bar)[XB_TMO], 1u); break; } } } } while (0)
struct XcdBarrier { unsigned* bar; unsigned x; volatile LAS unsigned* st; };
__device__ __forceinline__ XcdBarrier xcd_barrier_post(unsigned* bar, volatile LAS unsigned* st) {
    XcdBarrier b; b.bar = bar; b.x = xb_xcc_id(); b.st = st;
    if (tidx() == 0) (void)xb_add(&bar[XB_XCNT(b.x)], 1u);
    return b;
}
__device__ __forceinline__ void xcd_barrier_complete(unsigned* bar, unsigned x, unsigned& nloc, unsigned& nx) {
    const unsigned G = gridDim.x * gridDim.y * gridDim.z;
    unsigned sum, cnt, mine, sp = 0u;
    for (;;) {
        sum = 0u; cnt = 0u; mine = 0u;
#pragma unroll
        for (unsigned j = 0; j < 16; ++j) { const unsigned c = xb_ld(&bar[XB_XCNT(j)]); sum += c; cnt += (c > 0u) ? 1u : 0u; mine = (j == x) ? c : mine; }
        if (sum == G) break;
        __builtin_amdgcn_s_sleep(1);
        if ((++sp & 255u) == 0u) { if (xb_ld(&bar[XB_TMO])) break; if (sp > XB_SPIN_CAP) { atomicAdd(&bar[XB_TMO], 1u); break; } }
    }
    nloc = mine > 0u ? mine : 1u; nx = cnt > 0u ? cnt : 1u;
}
__device__ __forceinline__ void xcd_barrier(const XcdBarrier& b) {
    asm volatile("s_waitcnt vmcnt(0)" ::: "memory");
    __syncthreads();
    if (tidx() == 0) {
        unsigned* bar = b.bar;
        __builtin_amdgcn_s_waitcnt(0);
        unsigned nloc = b.st[0], nx = b.st[1];
        if (nloc == 0u) { xcd_barrier_complete(bar, b.x, nloc, nx); b.st[0] = nloc; b.st[1] = nx; }
        const unsigned old = xb_add(&bar[XB_XSUB(b.x)], 1u);
        const unsigned gen = old / nloc;
        if (old + 1u == (gen + 1u) * nloc) {
            __builtin_amdgcn_fence(__ATOMIC_RELEASE, "agent");
            asm volatile("s_waitcnt vmcnt(0)" ::: "memory");
            const unsigned og = xb_add(&bar[XB_TOP], 1u);
            const unsigned tg = og / nx;
            if (og + 1u == (tg + 1u) * nx) xb_add(&bar[XB_TOPGEN], 1u);
            else XB_SPIN(xb_ld(&bar[XB_TOPGEN]) == tg, bar);
            __builtin_amdgcn_fence(__ATOMIC_ACQUIRE, "agent");
            xb_add(&bar[XB_XGEN(b.x)], 1u);
            asm volatile("s_waitcnt vmcnt(0)" ::: "memory");
        } else {
            XB_SPIN(xb_ld(&bar[XB_XGEN(b.x)]) == gen, bar);
            __builtin_amdgcn_fence(__ATOMIC_ACQUIRE, "agent");
            asm volatile("s_waitcnt vmcnt(0)" ::: "memory");
        }
    }
    __syncthreads();
}

__device__ __forceinline__ void p0_transpose_item(const float* W, int K, int Nsrc, int lcol0, bf16* WT, int n0, int k0, const float* kscale, LAS float* scr, int lane) {
    {
        const int c4 = lane & 7; f32x4 v[8];
#pragma unroll
        for (int i = 0; i < 8; ++i) v[i] = (f32x4){0.f, 0.f, 0.f, 0.f};
        if (lcol0 >= 0) {
#pragma unroll
            for (int i = 0; i < 8; ++i) { const int kk = 8 * i + (lane >> 3); v[i] = *(const f32x4*)(W + (size_t)(k0 + kk) * Nsrc + lcol0 + 4 * c4); }
            if (kscale) { float ksc[8];
#pragma unroll
                for (int i = 0; i < 8; ++i) ksc[i] = kscale[k0 + 8 * i + (lane >> 3)];
#pragma unroll
                for (int i = 0; i < 8; ++i) v[i] = v[i] * ksc[i]; }
        }
#pragma unroll
        for (int i = 0; i < 8; ++i) { const int kk = 8 * i + (lane >> 3); LAS float* d = scr + kk * 33 + 4 * c4; d[0] = v[i][0]; d[1] = v[i][1]; d[2] = v[i][2]; d[3] = v[i][3]; }
    }
    LDS_WAIT(); asm volatile("" ::: "memory");
    const int c = lane & 7;
#pragma unroll
    for (int j = 0; j < 4; ++j) { const int n = (lane >> 3) + 8 * j; const LAS float* s = scr + (8 * c) * 33 + n;
        u32x4 o; o.x = pg8::cvt_pk_bf16(s[0 * 33], s[1 * 33]); o.y = pg8::cvt_pk_bf16(s[2 * 33], s[3 * 33]); o.z = pg8::cvt_pk_bf16(s[4 * 33], s[5 * 33]); o.w = pg8::cvt_pk_bf16(s[6 * 33], s[7 * 33]);
        *(u32x4*)(WT + (size_t)(n0 + n) * K + k0 + 8 * c) = o; }
    LDS_WAIT(); asm volatile("" ::: "memory");
}


__device__ __forceinline__ void router_block(int rb, LAS unsigned char* lds, const float* __restrict__ x1, const bf16* __restrict__ y1, const float* __restrict__ g2, const float* __restrict__ modp, const float* __restrict__ rw, const float* __restrict__ rbias,
                                             bf16* __restrict__ u2p, unsigned* __restrict__ ctlp, int* __restrict__ listp, float* __restrict__ topkwp) {
    typedef float f32x16 __attribute__((ext_vector_type(16)));
    const int tid = tidx(), lane = tid & 63, wv = __builtin_amdgcn_readfirstlane(tid >> 6), r32 = lane & 31, hi = lane >> 5;
    const int row0 = rb * 128, b = row0 >> 11;
    const float* shift = modp + b * 6144 + 3 * D, *scale = modp + b * 6144 + 4 * D;
    LAS float* CV = (LAS float*)(lds + 135168);
    LAS unsigned* LCNT = (LAS unsigned*)(CV + 448);
    if (tid < 64) LCNT[tid] = 0u;
    constexpr int XP = 132;
    LAS float* XT = (LAS float*)(lds + wv * 16896);
    bf16x8 bh[8], bl[8]; float cpart = 0.f;
#pragma unroll
    for (int ks = 0; ks < 8; ++ks) { unsigned ph[4], pl[4];
#pragma unroll
        for (int j2 = 0; j2 < 4; ++j2) { float wv2[2], hv[2];
#pragma unroll
            for (int q = 0; q < 2; ++q) { const int k = 128 * wv + 16 * ks + 8 * hi + 2 * j2 + q; const float rwv = rw[(size_t)k * NE + r32]; cpart += shift[k] * rwv; wv2[q] = g2[k] * (1.f + scale[k]) * rwv; }
            ph[j2] = pg8::cvt_pk_bf16(wv2[0], wv2[1]); hv[0] = __uint_as_float(ph[j2] << 16); hv[1] = __uint_as_float(ph[j2] & 0xffff0000u); pl[j2] = pg8::cvt_pk_bf16(wv2[0] - hv[0], wv2[1] - hv[1]); }
        u32x4 uh, ul; uh.x = ph[0]; uh.y = ph[1]; uh.z = ph[2]; uh.w = ph[3]; ul.x = pl[0]; ul.y = pl[1]; ul.z = pl[2]; ul.w = pl[3]; bh[ks] = __builtin_bit_cast(bf16x8, uh); bl[ks] = __builtin_bit_cast(bf16x8, ul); }
    cpart += __shfl_xor(cpart, 32);
    if (hi == 0) CV[wv * NE + r32] = cpart;
    LAS float* SS = (LAS float*)(lds + 137216);
    f32x4 gsA, gsB, shA, shB; { const int cb = 128 * wv + (lane & 15) * 8;
        gsA = *(const f32x4*)(g2 + cb) * (*(const f32x4*)(scale + cb) + 1.f); gsB = *(const f32x4*)(g2 + cb + 4) * (*(const f32x4*)(scale + cb + 4) + 1.f); shA = *(const f32x4*)(shift + cb); shB = *(const f32x4*)(shift + cb + 4); }
    f32x16 acc[4]; float ssq[4];
#pragma unroll
    for (int rt = 0; rt < 4; ++rt) {
        acc[rt] = f32x16{};
        const float* src = x1 + (size_t)(row0 + 32 * rt) * D + 128 * wv; const bf16* ysrc = y1 + (size_t)(row0 + 32 * rt) * D + 128 * wv;
#pragma unroll 1
        for (int i4 = 0; i4 < 16; i4 += 8) { f32x4 v[8]; u32x2 yv[8];
#pragma unroll
            for (int i = 0; i < 8; ++i) { const int id = (i4 + i) * 64 + lane; v[i] = *(const f32x4*)(src + (size_t)(id >> 5) * D + 4 * (id & 31)); yv[i] = *(const u32x2*)(ysrc + (size_t)(id >> 5) * D + 4 * (id & 31)); }
#pragma unroll
            for (int i = 0; i < 8; ++i) { const int id = (i4 + i) * 64 + lane; f32x4 t_ = v[i]; t_[0] += __uint_as_float(yv[i].x << 16); t_[1] += __uint_as_float(yv[i].x & 0xffff0000u); t_[2] += __uint_as_float(yv[i].y << 16); t_[3] += __uint_as_float(yv[i].y & 0xffff0000u);
                *(LAS f32x4*)(XT + (id >> 5) * XP + 4 * (id & 31)) = t_; } }
        asm volatile("s_waitcnt lgkmcnt(0)" ::: "memory");
        float s = 0.f;
#pragma unroll
        for (int ks = 0; ks < 8; ++ks) {
            const f32x4 a0 = *(const LAS f32x4*)(XT + r32 * XP + 16 * ks + 8 * hi), a1 = *(const LAS f32x4*)(XT + r32 * XP + 16 * ks + 8 * hi + 4);
            s += (a0[0] * a0[0] + a0[1] * a0[1]) + (a0[2] * a0[2] + a0[3] * a0[3]) + (a1[0] * a1[0] + a1[1] * a1[1]) + (a1[2] * a1[2] + a1[3] * a1[3]);
            u32x4 uh, ul; float h0, h1;
            uh.x = pg8::cvt_pk_bf16(a0[0], a0[1]); h0 = __uint_as_float(uh.x << 16); h1 = __uint_as_float(uh.x & 0xffff0000u); ul.x = pg8::cvt_pk_bf16(a0[0] - h0, a0[1] - h1);
            uh.y = pg8::cvt_pk_bf16(a0[2], a0[3]); h0 = __uint_as_float(uh.y << 16); h1 = __uint_as_float(uh.y & 0xffff0000u); ul.y = pg8::cvt_pk_bf16(a0[2] - h0, a0[3] - h1);
            uh.z = pg8::cvt_pk_bf16(a1[0], a1[1]); h0 = __uint_as_float(uh.z << 16); h1 = __uint_as_float(uh.z & 0xffff0000u); ul.z = pg8::cvt_pk_bf16(a1[0] - h0, a1[1] - h1);
            uh.w = pg8::cvt_pk_bf16(a1[2], a1[3]); h0 = __uint_as_float(uh.w << 16); h1 = __uint_as_float(uh.w & 0xffff0000u); ul.w = pg8::cvt_pk_bf16(a1[2] - h0, a1[3] - h1);
            const bf16x8 ah = __builtin_bit_cast(bf16x8, uh), al = __builtin_bit_cast(bf16x8, ul);
            acc[rt] = __builtin_amdgcn_mfma_f32_32x32x16_bf16(ah, bh[ks], acc[rt], 0, 0, 0);
            acc[rt] = __builtin_amdgcn_mfma_f32_32x32x16_bf16(al, bh[ks], acc[rt], 0, 0, 0);
            acc[rt] = __builtin_amdgcn_mfma_f32_32x32x16_bf16(ah, bl[ks], acc[rt], 0, 0, 0);
        }
        ssq[rt] = s + __shfl_xor(s, 32);
        if (hi == 0) SS[(rt * 8 + wv) * 32 + r32] = ssq[rt];
        __syncthreads();
        {   float tot = 0.f;
#pragma unroll
            for (int q = 0; q < 8; ++q) tot += SS[(rt * 8 + q) * 32 + r32];
            const float rsv = rsqrtf(tot * (1.f / D) + EPS);
#pragma unroll
            for (int i = 0; i < 8; ++i) { const int row = 4 * i + (lane >> 4), c8 = (lane & 15) * 8; const float rsr = __shfl(rsv, row);
                const f32x4 xa = *(const LAS f32x4*)(XT + row * XP + c8), xb = *(const LAS f32x4*)(XT + row * XP + c8 + 4);
                const f32x4 oa = xa * rsr * gsA + shA, ob = xb * rsr * gsB + shB;
                u32x4 w; w.x = pg8::cvt_pk_bf16(oa[0], oa[1]); w.y = pg8::cvt_pk_bf16(oa[2], oa[3]); w.z = pg8::cvt_pk_bf16(ob[0], ob[1]); w.w = pg8::cvt_pk_bf16(ob[2], ob[3]);
                *(u32x4*)(u2p + (size_t)(row0 + 32 * rt + row) * D + 128 * wv + c8) = w; }
        }
        asm volatile("s_waitcnt lgkmcnt(0)" ::: "memory");
    }
    __syncthreads();
    {
        LAS float* P = (LAS float*)lds + (size_t)wv * 128 * 33;
#pragma unroll
        for (int rt = 0; rt < 4; ++rt) {
#pragma unroll
            for (int r = 0; r < 16; ++r) P[(32 * rt + (r & 3) + 8 * (r >> 2) + 4 * hi) * 33 + r32] = acc[rt][r];
            if (hi == 0) P[(32 * rt + r32) * 33 + 32] = ssq[rt]; }
    }
    __syncthreads();
    if (tid < NE) { float s = rbias[tid];
#pragma unroll
        for (int q = 0; q < 8; ++q) s += CV[q * NE + tid];
        CV[256 + tid] = s; }
    __syncthreads();
    if (tid < 128) {
        const LAS float* P = (const LAS float*)lds + tid * 33;
        float lg[NE]; float sq = 0.f;
#pragma unroll
        for (int e = 0; e < NE; ++e) lg[e] = 0.f;
#pragma unroll
        for (int q = 0; q < 8; ++q) {
#pragma unroll
            for (int e = 0; e < NE; ++e) lg[e] += P[q * 128 * 33 + e];
            sq += P[q * 128 * 33 + 32]; }
        const float rs = rsqrtf(sq * (1.f / D) + EPS);
        CV[320 + tid] = rs;
#pragma unroll
        for (int e = 0; e < NE; ++e) lg[e] = lg[e] * rs + CV[256 + e];
        unsigned taken = 0u; int te[4]; float tl[4];
#pragma unroll
        for (int k = 0; k < 4; ++k) { float best = -INFINITY; int bi = 0;
#pragma unroll
            for (int e = 0; e < NE; ++e) { const float cand = ((taken >> e) & 1u) ? -INFINITY : lg[e]; if (cand > best) { best = cand; bi = e; } }
            taken |= 1u << bi; te[k] = bi; tl[k] = best; }
        const float w1 = __expf(tl[1] - tl[0]), w2 = __expf(tl[2] - tl[0]), w3 = __expf(tl[3] - tl[0]), inv = 1.f / ((1.f + w1) + (w2 + w3));
        const float wk[4] = {inv, w1 * inv, w2 * inv, w3 * inv};
        const int row = row0 + tid;
        unsigned lr[4];
#pragma unroll
        for (int k = 0; k < 4; ++k) lr[k] = __hip_atomic_fetch_add(LCNT + te[k], 1u, __ATOMIC_RELAXED, __HIP_MEMORY_SCOPE_WORKGROUP);
        __syncthreads();
        if (tid < NE) LCNT[32 + tid] = atomicAdd(&ctlp[CW_COUNTS + tid], LCNT[tid]);
        __syncthreads();
#pragma unroll
        for (int k = 0; k < 4; ++k) { listp[te[k] * LISTCAP + LCNT[32 + te[k]] + lr[k]] = row * 4 + k; topkwp[row * 4 + k] = wk[k]; }
    } else { __syncthreads(); __syncthreads(); }
    __syncthreads();
    __syncthreads();
}

struct Args { const float* in[26]; float* out; unsigned char* ws; int ph_lo, ph_hi, li, pad; };
constexpr int WGM_INPROJ = 6, WGM_MRG = 4, WGM_MOE1 = 4, WGM_MOE2 = 4;
enum { PH_PRO = 0, PH_NORM1, PH_INPROJ, PH_MIX1, PH_MIX2, PH_GNORM, PH_MRGA, PH_MRGB, PH_OUT, PH_ROUTER, PH_MOE1, PH_MOE2, PH_FINAL, PH_COUNT };

__global__ void __launch_bounds__(NWAVES * 64, 2) mega(Args args_unused) {
    typedef const __attribute__((address_space(4))) Args* ArgP;
    ArgP ap = (ArgP)__builtin_amdgcn_kernarg_segment_ptr();
    asm volatile("" : "+s"(ap));
    extern __shared__ __attribute__((aligned(16))) unsigned char lds_raw[];
    LAS unsigned char* lds = (LAS unsigned char*)lds_raw;
    volatile LAS int* LCTL = (volatile LAS int*)(lds + LCTL_OFF);
    const int G = gridDim.x, bx = blockIdx.x, NGW = G * NWAVES;
#define PHASE_IDS() const int tid = tidx(), lane = tid & 63, wave = __builtin_amdgcn_readfirstlane(tid >> 6), gw = bx * NWAVES + wave; (void)tid; (void)lane; (void)wave; (void)gw
#define ws (ap->ws)
#define ctl ((unsigned*)(ws + OFF_CTL))
#define xin (ap->in[0])
#define out (ap->out)
#define mod ((float*)(ws + OFF_MOD))
#define relb ((float*)(ws + OFF_RELB))
#define kmean ((float*)(ws + OFF_KMEAN))
#define topkw ((float*)(ws + OFF_TOPKW))
#define list ((int*)(ws + OFF_LIST))
#define dtraw ((float*)(ws + OFF_DTRAW))
#define WinT ((bf16*)(ws + OFF_WIN))
#define WaT ((bf16*)(ws + OFF_WA))
#define WsT ((bf16*)(ws + OFF_WS))
#define WoT ((bf16*)(ws + OFF_WO))
#define W1T ((bf16*)(ws + OFF_W1))
#define W2T ((bf16*)(ws + OFF_W2))
#define ub ((bf16*)(ws + OFF_U))
#define cat ((bf16*)(ws + OFF_CAT))
#define kb ((bf16*)(ws + OFF_K))
#define vb ((bf16*)(ws + OFF_V))
#define xs ((bf16*)(ws + OFF_XS))
#define brw ((bf16*)(ws + OFF_BR))
#define crw ((bf16*)(ws + OFF_CR))
#define gates ((bf16*)(ws + OFF_GATES))
#define u2 ((bf16*)(ws + OFF_U2))
#define hb ((bf16*)(ws + OFF_HB))
#define yb ((bf16*)(ws + OFF_YB))
#define merged kb
    {
        const int t0 = (int)__builtin_amdgcn_workitem_id_x();
        for (int i = t0; i < (LDS_BYTES - LCTL_OFF) / 4; i += NWAVES * 64) ((LAS unsigned*)(lds + LCTL_OFF))[i] = 0u;
        __syncthreads();
        if ((t0 & 63) == 0) LCTL[192 + hw_wave_slot()] = t0 >> 6;
        __syncthreads();
    }
    const int lo = ap->ph_lo, hi = ap->ph_hi;
    XcdBarrier bar; bar.bar = ctl + CW_BAR + ap->li * XCD_BAR_WORDS; bar.x = 0; bar.st = nullptr;
    if (hi - lo > 1) bar = xcd_barrier_post(ctl + CW_BAR + ap->li * XCD_BAR_WORDS, (volatile LAS unsigned*)(LCTL + 128));
#define IN(k) (lo <= (k) && (k) < hi)
#define SEAM(k) do { if (IN(k) && IN((k) + 1)) xcd_barrier(bar); } while (0)
    constexpr int QI_IN = 16 * (NPROJ_PAD / 32), QI_A = 16 * 32, QI_S = 32 * 32, QI_O = 16 * 32, NQ0 = QI_IN + QI_A + QI_S + QI_O;
    constexpr int QI_1 = 16 * 64, QI_2 = 16 * 32, NQ1 = NQ0 + NE * QI_1, NQ = NQ1 + NE * QI_2;
    auto conv_batch = [&]() __attribute__((always_inline)) -> int {
        const int tid = tidx(), lane = tid & 63, wave = __builtin_amdgcn_readfirstlane(tid >> 6);
        if (tid == 0) LCTL[150] = (int)__hip_atomic_fetch_add(ctl + CW_QHEAD, 8u, RLX_AGENT);
        __syncthreads();
        const int base = __builtin_amdgcn_readfirstlane(LCTL[150]);
        __syncthreads();
        if (base >= NQ) return -1;
        int r = base + wave; LAS float* scr = (LAS float*)(lds + wave * 16384);
        const float* W_; bf16* WT_; const float* ks_ = nullptr; int K_, Ns_, lc_, n0_, k0_;
        if (r < QI_IN) { const int nb = r % (NPROJ_PAD / 32), kb_ = r / (NPROJ_PAD / 32); W_ = ap->in[5]; K_ = D; Ns_ = NPROJ; lc_ = win_logical(nb * 32); WT_ = WinT; n0_ = nb * 32; k0_ = kb_ * 64; }
        else if (r < QI_IN + QI_A) { r -= QI_IN; const int nb = r % 32, kb_ = r / 32; W_ = ap->in[15]; K_ = D; Ns_ = D; lc_ = nb * 32; WT_ = WaT; n0_ = nb * 32; k0_ = kb_ * 64; }
        else if (r < QI_IN + QI_A + QI_S) { r -= QI_IN + QI_A; const int nb = r % 32, kb_ = r / 32; W_ = ap->in[16]; K_ = SI; Ns_ = D; lc_ = nb * 32; WT_ = WsT; n0_ = nb * 32; k0_ = kb_ * 64; ks_ = ap->in[14]; }
        else if (r < NQ0) { r -= QI_IN + QI_A + QI_S; const int nb = r % 32, kb_ = r / 32; W_ = ap->in[18]; K_ = D; Ns_ = D; lc_ = nb * 32; WT_ = WoT; n0_ = nb * 32; k0_ = kb_ * 64; }
        else if (r < NQ1) { r -= NQ0; const int e = r / QI_1, q = r % QI_1, nb = q % 64, kb_ = q / 64; W_ = ap->in[22] + (size_t)e * D * 2048; K_ = D; Ns_ = 2048; lc_ = w1_logical(nb * 32); WT_ = W1T + (size_t)e * 2048 * D; n0_ = nb * 32; k0_ = kb_ * 64; }
        else { r -= NQ1; const int e = r / QI_2, q = r % QI_2, nb = q % 32, kb_ = q / 32; W_ = ap->in[24] + (size_t)e * FF * D; K_ = FF; Ns_ = D; lc_ = nb * 32; WT_ = W2T + (size_t)e * D * FF; n0_ = nb * 32; k0_ = kb_ * 64; }
        p0_transpose_item(W_, K_, Ns_, lc_, WT_, n0_, k0_, ks_, scr, lane);
        return base;
    };
    auto barrier_work = [&]() __attribute__((always_inline)) {
        asm volatile("s_waitcnt vmcnt(0)" ::: "memory");
        __syncthreads();
        unsigned gen = 0u; unsigned* barw = bar.bar;
        if (tidx() == 0) {
            __builtin_amdgcn_s_waitcnt(0);
            unsigned nloc = bar.st[0], nx = bar.st[1];
            if (nloc == 0u) { xcd_barrier_complete(barw, bar.x, nloc, nx); bar.st[0] = nloc; bar.st[1] = nx; }
            const unsigned old = xb_add(&barw[XB_XSUB(bar.x)], 1u);
            gen = old / nloc;
            const bool lastx = (old + 1u == (gen + 1u) * nloc);
            LCTL[151] = lastx ? 1 : 0;
            if (lastx) {
                __builtin_amdgcn_fence(__ATOMIC_RELEASE, "agent");
                asm volatile("s_waitcnt vmcnt(0)" ::: "memory");
                const unsigned og = xb_add(&barw[XB_TOP], 1u);
                const unsigned tg = og / nx;
                if (og + 1u == (tg + 1u) * nx) xb_add(&barw[XB_TOPGEN], 1u);
                else XB_SPIN(xb_ld(&barw[XB_TOPGEN]) == tg, barw);
                __builtin_amdgcn_fence(__ATOMIC_ACQUIRE, "agent");
                xb_add(&barw[XB_XGEN(bar.x)], 1u);
                asm volatile("s_waitcnt vmcnt(0)" ::: "memory");
            }
        }
        __syncthreads();
        if (LCTL[151] == 0) {
            for (;;) {
                if (tidx() == 0) LCTL[153] = (xb_ld(&barw[XB_XGEN(bar.x)]) != gen || xb_ld(&barw[XB_TMO])) ? 1 : 0;
                __syncthreads();
                const int rel = LCTL[153];
                if (rel) break;
                if (conv_batch() < 0) { if (tidx() == 0) { XB_SPIN(xb_ld(&barw[XB_XGEN(bar.x)]) == gen, barw); } break; }
            }
            asm volatile("s_waitcnt vmcnt(0)" ::: "memory");
            if (tidx() == 0) { __builtin_amdgcn_fence(__ATOMIC_ACQUIRE, "agent"); asm volatile("s_waitcnt vmcnt(0)" ::: "memory"); }
        }
        __syncthreads();
    };
#define SEAMW(k) do { if (IN(k) && IN((k) + 1)) barrier_work(); } while (0)

    if (IN(PH_PRO)) {
        PHASE_IDS();
        const float* c = ap->in[1]; const float* ada_w = ap->in[2]; const float* ada_b = ap->in[3];
        const int gt = bx * (NWAVES * 64) + tid;
        if (bx < 192) {
            LAS float* csT = (LAS float*)lds;
            { float cv[32];
#pragma unroll
              for (int q = 0; q < 32; ++q) cv[q] = c[tid + q * (NWAVES * 64)];
#pragma unroll
              for (int q = 0; q < 32; ++q) { const int i = tid + q * (NWAVES * 64); csT[(i & 1023) * 16 + (i >> 10)] = siluf(cv[q]); } }
            __syncthreads();
            const int col = tid & 31, ks = tid >> 5, j = bx * 32 + col;
            f32x4 a0 = {0.f, 0.f, 0.f, 0.f}, a1 = a0, a2 = a0, a3 = a0;
            const float* wp = ada_w + (size_t)(ks * 64) * 6144 + j; const LAS f32x4* cp = (const LAS f32x4*)(csT + ks * 64 * 16);
#pragma unroll 32
            for (int k = 0; k < 64; ++k) { const float wv = wp[(size_t)k * 6144]; a0 += cp[4 * k] * wv; a1 += cp[4 * k + 1] * wv; a2 += cp[4 * k + 2] * wv; a3 += cp[4 * k + 3] * wv; }
            LAS float* red = (LAS float*)(lds + 65536);
#pragma unroll
            for (int e = 0; e < 4; ++e) { red[(ks * 16 + e) * 32 + col] = a0[e]; red[(ks * 16 + 4 + e) * 32 + col] = a1[e]; red[(ks * 16 + 8 + e) * 32 + col] = a2[e]; red[(ks * 16 + 12 + e) * 32 + col] = a3[e]; }
            __syncthreads();
            { const int b = tid >> 5, cc = tid & 31; float sm = 0.f;
#pragma unroll
              for (int q = 0; q < 16; ++q) sm += red[(q * 16 + b) * 32 + cc];
              mod[b * 6144 + bx * 32 + cc] = ada_b[bx * 32 + cc] + sm; }
            __syncthreads();
        }
        if (gt < NH * SEQ) { const int d = gt & (SEQ - 1), h = gt >> 11; int bucket = d;
            if (d >= 16) bucket = 16 + (d >= 21) + (d >= 27) + (d >= 35) + (d >= 46) + (d >= 59) + (d >= 77) + (d >= 99) + (d >= 128) + (d >= 166) + (d >= 216) + (d >= 280) + (d >= 363) + (d >= 470) + (d >= 609) + (d >= 790);
            relb[gt] = ap->in[8][bucket * NH + h] * LOG2E; }
        if (gt < NBATCH * 8 * NH * HD) kmean[gt] = 0.f;
        __syncthreads();
        for (;;) { const int qb_ = conv_batch(); if (qb_ < 0 || qb_ >= NQ0) break; }
    }
    SEAMW(PH_PRO);
    if (IN(PH_NORM1)) {
        PHASE_IDS();
        const float* g1 = ap->in[4];
        for (int row0 = gw; row0 < T; row0 += 4 * NGW) {
            f32x4 v[4][4];
#pragma unroll
            for (int q = 0; q < 4; ++q) { const int row = row0 + q * NGW < T ? row0 + q * NGW : row0;
#pragma unroll
                for (int j = 0; j < 4; ++j) v[q][j] = *(const f32x4*)(xin + (size_t)row * D + 4 * lane + 256 * j); }
#pragma unroll
            for (int q = 0; q < 4; ++q) { const int row = row0 + q * NGW; if (row >= T) break;
                const int b = row >> 11; float s = 0.f;
#pragma unroll
                for (int j = 0; j < 4; ++j) s += (v[q][j].x * v[q][j].x + v[q][j].y * v[q][j].y) + (v[q][j].z * v[q][j].z + v[q][j].w * v[q][j].w);
                const float rs = rsqrtf(wave_sum(s) * (1.f / D) + EPS);
                const float* shift = mod + b * 6144, *scale = shift + D;
#pragma unroll
                for (int j = 0; j < 4; ++j) { const int col = 4 * lane + 256 * j; const f32x4 gg = *(const f32x4*)(g1 + col), sc = *(const f32x4*)(scale + col), sh = *(const f32x4*)(shift + col);
                    const f32x4 o = v[q][j] * rs * gg * (sc + 1.f) + sh; u32x2 w; w.x = pg8::cvt_pk_bf16(o[0], o[1]); w.y = pg8::cvt_pk_bf16(o[2], o[3]); *(u32x2*)(ub + (size_t)row * D + col) = w; }
            }
        }
    }
    SEAMW(PH_NORM1);
    if (IN(PH_INPROJ)) {
        pg8::Gemm g{nullptr, D, D, D}; pg8::StaticOrder S; S.init(T, NPROJ_MAIN, G, bx, ub, D, WinT, D, WGM_INPROJ);
        epi::EpiInProj E{ws, ap->in[6], ap->in[7], kmean};
        pg8::gemm_phase<epi::EpiInProj, pg8::StaticOrder, false>(lds, g, S, E, nullptr);
        pg8::StaticOrder S2; S2.init(T, 256, G, bx, ub, D, WinT + (size_t)NPROJ_MAIN * D, D, 1);
        epi::EpiDt E2{ws};
        pg8::gemm_phase<epi::EpiDt, pg8::StaticOrder, false, true>(lds, g, S2, E2, nullptr);
    }
    SEAMW(PH_INPROJ);
    if (IN(PH_MIX1)) {
        bf16* Ccg = (bf16*)(ws + OFF_U); bf16* BcTg = (bf16*)(ws + OFF_U + 32 * MiB); bf16* CBm = (bf16*)(ws + OFF_CB);
        for (int un = bx; un < NBATCH * ssd::NCH * SG; un += G) ssd::pre_unit(un, lds, brw, crw, ap->in[9], ap->in[10], CBm, Ccg, BcTg);
        __syncthreads();
        const int vcu = (G % 8 == 0) ? (bx % 8) * (G / 8) + bx / 8 : bx;
        if (ap->pad != 2) for (int bh = vcu; bh < NBATCH * NH; bh += G) {
            const int b = bh >> 4, h = bh & 15;
            attn_body::fill_tables((char*)lds_raw, relb + h * SEQ); __syncthreads();
            bf16* Op = ap->pad ? (bf16*)(ws + OFF_YB) : cat; asm volatile("" : "+s"(Op));
            for (int qb = 7; qb >= 0; --qb) attn_body::attn_unit<8>(b, h, qb, cat, kb, vb, Op, kmean + ((size_t)b * 8 * NH + h) * 64, (char*)lds_raw);
            __syncthreads();
        }
    }
    SEAMW(PH_MIX1);
    if (IN(PH_MIX2)) {
        PHASE_IDS();
        const bf16* Ccg = (const bf16*)(ws + OFF_U); const bf16* BcTg = (const bf16*)(ws + OFF_U + 32 * MiB); const bf16* CBm = (const bf16*)(ws + OFF_CB);
        for (int pr = bx; pr < NBATCH * SH / 2; pr += G)
            ssd::main_pair(2 * pr + (wave >> 2), lds, cat, ap->pad ? (bf16*)(ws + OFF_YB) : cat, ap->pad ? (float*)(ws + OFF_YB) : (float*)(ws + OFF_SSQ), xs, dtraw, CBm, Ccg, BcTg, ap->in[9], ap->in[10], ap->in[11], ap->in[12], ap->in[13]);
    }
    SEAMW(PH_MIX2);
    if (IN(PH_MRGA)) {
        pg8::Gemm g{nullptr, CATP, D, D}; pg8::StaticOrder S; S.init(T, D, G, bx, cat, CATP, WaT, D, WGM_MRG);
        epi::EpiMergedA E{ws, ap->in[17], (LAS float*)(lds + TAB_OFF)};
        pg8::gemm_phase<epi::EpiMergedA, pg8::StaticOrder, false>(lds, g, S, E, nullptr);
    }
    if (IN(PH_MRGB)) {
        pg8::Gemm g{nullptr, CATP, SI, SI}; pg8::StaticOrder S; S.init(T, D, G, bx, cat + 1024, CATP, WsT, SI, WGM_MRG);
        epi::EpiMergedB E{ws, ap->in[17], (const LAS float*)(lds + TAB_OFF)};
        pg8::gemm_phase<epi::EpiMergedB, pg8::StaticOrder, false>(lds, g, S, E, nullptr);
    }
    SEAMW(PH_MRGB);
    if (IN(PH_OUT)) {
        pg8::Gemm g{nullptr, D, D, D}; pg8::StaticOrder S; S.init(T, D, G, bx, merged, D, WoT, D, WGM_MRG);
        epi::EpiOut E{mod, (bf16*)(ws + OFF_Y1)};
        pg8::gemm_phase<epi::EpiOut, pg8::StaticOrder, false>(lds, g, S, E, nullptr);
    }
    SEAMW(PH_OUT);
    if (IN(PH_ROUTER)) {
        const bool dry = ap->pad == 1;
        for (int rb = bx; rb < T / 128; rb += G) router_block(rb, lds, xin, (const bf16*)(ws + OFF_Y1), ap->in[19], mod, ap->in[20], ap->in[21], u2, dry ? ctl + 64 : ctl, dry ? (int*)(ws + OFF_YB) : list, dry ? (float*)(ws + OFF_YB + 8 * MiB) : topkw);
    }
    if (IN(PH_ROUTER)) { __syncthreads(); for (;;) { const int qb_ = conv_batch(); if (qb_ < 0 || qb_ >= NQ1) break; } }
    SEAMW(PH_ROUTER);
    if (IN(PH_MOE1) || IN(PH_MOE2)) {
        PHASE_IDS();
        if (tid < 64) {
            const int cnt = tid < NE ? (int)__hip_atomic_load(ctl + CW_COUNTS + tid, RLX_AGENT) : 0; const int tiles = (cnt + 255) >> 8; int incl = tiles;
#pragma unroll
            for (int o = 1; o < 32; o <<= 1) { const int t_ = __shfl_up(incl, o); if (lane >= o) incl += t_; }
            if (tid < NE) { LCTL[tid] = incl - tiles; LCTL[64 + tid] = cnt; }
            if (tid == NE - 1) LCTL[NE] = incl;
        }
        __syncthreads();
    }
    if (IN(PH_MOE1)) {
        PHASE_IDS();
        pg8::MoeOrder S; S.init(LCTL, 2048, G, bx, nullptr, D, W1T, D, (size_t)2048 * D * 2, WGM_MOE1);
        LAS unsigned* tab = (LAS unsigned*)(lds + TAB_OFF);
        { pg8::Unit u; for (int i = wave; S.next(i, u); i += NWAVES) {
              const int sb = (u.pm - LCTL[u.e]) * 256 + lane, cnt = LCTL[64 + u.e]; const int* le = list + u.e * LISTCAP; int ent[4];
#pragma unroll
              for (int j = 0; j < 4; ++j) { const int slot = sb + 64 * j; ent[j] = le[slot < cnt ? slot : 0]; }
#pragma unroll
              for (int j = 0; j < 4; ++j) tab[i * 256 + lane + 64 * j] = (unsigned)(ent[j] >> 2) * (unsigned)(D * 2); } }
        __syncthreads();
        pg8::Gemm g{(const char*)u2, D, D, D};
        epi::EpiMoe1 E{ap->in[23], hb};
        pg8::gemm_phase<epi::EpiMoe1, pg8::MoeOrder, true>(lds, g, S, E, tab);
    }
    if (IN(PH_MOE1)) { __syncthreads(); while (conv_batch() >= 0) { } }
    SEAM(PH_MOE1);
    if (IN(PH_MOE2)) {
        PHASE_IDS();
        pg8::MoeOrder S; S.init(LCTL, D, G, bx, hb, FF, W2T, FF, (size_t)D * FF * 2, WGM_MOE2);
        LAS int* tabE = (LAS int*)(lds + TAB_OFF); LAS float* tabW = (LAS float*)(lds + TAB_OFF + 12288);
        { pg8::Unit u; for (int i = wave; S.next(i, u); i += NWAVES) {
              const int sb = (u.pm - LCTL[u.e]) * 256 + lane, cnt = LCTL[64 + u.e]; const int* le = list + u.e * LISTCAP; int ent[4]; float wv[4];
#pragma unroll
              for (int j = 0; j < 4; ++j) { const int slot = sb + 64 * j; ent[j] = slot < cnt ? le[slot] : -1; }
#pragma unroll
              for (int j = 0; j < 4; ++j) wv[j] = ent[j] >= 0 ? topkw[ent[j]] : 0.f;
#pragma unroll
              for (int j = 0; j < 4; ++j) { tabE[i * 256 + lane + 64 * j] = ent[j]; tabW[i * 256 + lane + 64 * j] = wv[j]; } } }
        __syncthreads();
        pg8::Gemm g{nullptr, FF, FF, FF};
        epi::EpiMoe2 E{ap->in[25], yb, tabE, tabW};
        pg8::gemm_phase<epi::EpiMoe2, pg8::MoeOrder, false>(lds, g, S, E, nullptr);
    }
    SEAM(PH_MOE2);
    if (IN(PH_FINAL)) {
        PHASE_IDS();
        const int gt = bx * (NWAVES * 64) + tid, NT = G * NWAVES * 64;
        constexpr int FU = 2;
        for (size_t i8 = gt; i8 < (size_t)T * D / 8; i8 += (size_t)FU * NT) {
            u32x4 yq[FU][4], y1q[FU]; f32x4 xa[FU], xb[FU], gA[FU], gB[FU]; float* dst = ap->pad == 1 ? (float*)(ws + OFF_HB) : out;
#pragma unroll
            for (int u = 0; u < FU; ++u) { const size_t j8 = i8 + (size_t)u * NT < (size_t)T * D / 8 ? i8 + (size_t)u * NT : i8; const size_t idx = j8 * 8; const int t = (int)(idx >> 10), n = (int)(idx & 1023), b = t >> 11;
#pragma unroll
                for (int k = 0; k < 4; ++k) yq[u][k] = *(const u32x4*)(yb + ((size_t)t * 4 + k) * D + n);
                const float* g2 = mod + b * 6144 + 5 * D + n; gA[u] = *(const f32x4*)(g2); gB[u] = *(const f32x4*)(g2 + 4);
                y1q[u] = *(const u32x4*)((const bf16*)(ws + OFF_Y1) + idx); xa[u] = *(const f32x4*)(xin + idx); xb[u] = *(const f32x4*)(xin + idx + 4); }
#pragma unroll
            for (int u = 0; u < FU; ++u) { const size_t j8 = i8 + (size_t)u * NT; if (j8 >= (size_t)T * D / 8) break; const size_t idx = j8 * 8;
                f32x4 s0 = {0.f, 0.f, 0.f, 0.f}, s1 = {0.f, 0.f, 0.f, 0.f};
#pragma unroll
                for (int k = 0; k < 4; ++k) { f32x4 a, c; epi::unpack8(yq[u][k], a, c); s0 += a; s1 += c; }
                f32x4 ya, yc; epi::unpack8(y1q[u], ya, yc);
                *(f32x4*)(dst + idx) = (xa[u] + ya) + gA[u] * s0; *(f32x4*)(dst + idx + 4) = (xb[u] + yc) + gB[u] * s1; }
        }
    }
#undef IN
#undef SEAM
#undef PHASE_IDS
#undef ws
#undef ctl
#undef xin
#undef out
#undef mod
#undef relb
#undef kmean
#undef topkw
#undef list
#undef dtraw
#undef WinT
#undef WaT
#undef WsT
#undef WoT
#undef W1T
#undef W2T
#undef ub
#undef cat
#undef kb
#undef vb
#undef xs
#undef brw
#undef crw
#undef gates
#undef u2
#undef hb
#undef yb
#undef merged
}
static void launch_mega(const Args& base, int lo, int hi, int li, hipStream_t stream) {
    Args a = base; a.ph_lo = lo; a.ph_hi = hi; a.li = li;
    hipLaunchKernelGGL(mega, dim3(256), dim3(NWAVES * 64), LDS_BYTES, stream, a);
}
extern "C" void kernel_launch(void* const* d_in, const int* in_sizes, int n_in, void* d_out, int out_size, void* d_ws, size_t ws_size, hipStream_t stream) {
    if (n_in != 26 || ws_size < WS_NEED || out_size != T * D) { fprintf(stderr, "kernel_launch: unexpected sizes (n_in %d ws %zu out %d)\n", n_in, ws_size, out_size); return; }
    static bool attr_set = false;
    if (!attr_set) { (void)hipFuncSetAttribute((const void*)mega, hipFuncAttributeMaxDynamicSharedMemorySize, LDS_BYTES); attr_set = true; }
    const float* conv_w = (const float*)d_in[9]; const float* conv_b = (const float*)d_in[10]; const float* dt_bias = (const float*)d_in[11];
    const float* a_log = (const float*)d_in[12]; const float* d_skip = (const float*)d_in[13]; const float* norm2_g = (const float*)d_in[19];
    const float* router_w = (const float*)d_in[20]; const float* router_b = (const float*)d_in[21];
    char* ws = (char*)d_ws; float* out = (float*)d_out;
    unsigned* ctl = (unsigned*)(ws + OFF_CTL); float* mod = (float*)(ws + OFF_MOD); float* relb = (float*)(ws + OFF_RELB); float* kmean = (float*)(ws + OFF_KMEAN);
    float* topkw = (float*)(ws + OFF_TOPKW); int* list = (int*)(ws + OFF_LIST); float* dtraw = (float*)(ws + OFF_DTRAW);
    bf16* cat = (bf16*)(ws + OFF_CAT); bf16* kb = (bf16*)(ws + OFF_K); bf16* vb = (bf16*)(ws + OFF_V); bf16* xs = (bf16*)(ws + OFF_XS);
    bf16* brw = (bf16*)(ws + OFF_BR); bf16* crw = (bf16*)(ws + OFF_CR); bf16* u2 = (bf16*)(ws + OFF_U2);
    Args a{};
    for (int i = 0; i < 26; ++i) a.in[i] = (const float*)d_in[i];
    a.out = out; a.ws = (unsigned char*)d_ws;
    (void)hipMemsetAsync(ws + OFF_CTL, 0, 1 * MiB, stream);
    launch_mega(a, PH_PRO, PH_COUNT, 0, stream);
}
```
